# Optimizing an MI355X kernel written in HIP

```python
import jax, jax.numpy as jnp
from jax import lax
import numpy as np

D_MODEL = 1024
BATCH = 8
SEQ = 4096
DEPTH = 2

HEAD_DIM = 64
A_HEADS = 6
DILATED_PATTERNS = ((128, 1), (512, 4), (2048, 16))
CONV_CH = 256
CONV_K = 3
C_Q_HEADS = 6
C_KV_HEADS = 2
C_GROUP = C_Q_HEADS // C_KV_HEADS
C_WINDOW = 128
BLOCK = 128
D_FF = 4 * D_MODEL
EPS = 1e-6

A_WIDTH = A_HEADS * HEAD_DIM
C_WIDTH = C_Q_HEADS * HEAD_DIM
KV_WIDTH = C_KV_HEADS * HEAD_DIM
MIX_WIDTH = A_WIDTH + CONV_CH + C_WIDTH
IN_SPLITS = (A_WIDTH, A_WIDTH, A_WIDTH, CONV_CH, CONV_CH, CONV_CH, C_WIDTH, KV_WIDTH, KV_WIDTH)
IN_WIDTH = sum(IN_SPLITS)
SPLIT_POINTS = tuple(int(p) for p in np.cumsum(IN_SPLITS)[:-1])

kernel_name = "hymba_dilated_conv_swa_sink_trunk"


def rms_normalize(t):
    t32 = t.astype(jnp.float32)
    return (t32 * lax.rsqrt(jnp.mean(t32 * t32, axis=-1, keepdims=True) + EPS)).astype(t.dtype)


def rmsnorm(t, g):
    return rms_normalize(t) * g


def banded_attention(q, k, v, max_dist, sink_logits=None):
    n, L, hkv, g, dh = q.shape
    nb = -(-L // BLOCK)
    lp = nb * BLOCK
    pad = lp - L
    q = jnp.pad(q, ((0, 0), (0, pad), (0, 0), (0, 0), (0, 0)))
    kv_pad = ((0, 0), (BLOCK, pad), (0, 0), (0, 0))
    k = jnp.pad(k, kv_pad).reshape(n, nb + 1, BLOCK, hkv, dh)
    v = jnp.pad(v, kv_pad).reshape(n, nb + 1, BLOCK, hkv, dh)
    k2 = jnp.concatenate([k[:, :-1], k[:, 1:]], axis=2)
    v2 = jnp.concatenate([v[:, :-1], v[:, 1:]], axis=2)
    qb = q.reshape(n, nb, BLOCK, hkv, g, dh)
    s = jnp.einsum('nbqhgd,nbkhd->nbhgqk', qb, k2).astype(jnp.float32) * (dh ** -0.5)
    qi = jnp.arange(BLOCK)[:, None]
    kj = jnp.arange(2 * BLOCK)[None, :]
    dist = BLOCK + qi - kj
    band = (dist >= 0) & (dist <= max_dist)
    first = jnp.arange(nb)[:, None, None] == 0
    mask = band[None] & ~(first & (kj < BLOCK)[None])
    s = jnp.where(mask[None, :, None, None], s, -jnp.inf)
    if sink_logits is not None:
        sink = jnp.broadcast_to(sink_logits.astype(jnp.float32)[None, None, :, :, None, None], s.shape[:-1] + (1,))
        lse = jax.nn.logsumexp(jnp.concatenate([s, sink], axis=-1), axis=-1)
    else:
        lse = jax.nn.logsumexp(s, axis=-1)
    p = jnp.exp(s - lse[..., None]).astype(v2.dtype)
    o = jnp.einsum('nbhgqk,nbkhd->nbqhgd', p, v2).reshape(n, lp, hkv, g, dh)[:, :L]
    lse = lse.transpose(0, 1, 4, 2, 3).reshape(n, lp, hkv, g)[:, :L]
    return o, lse


def to_residues(t, dil):
    b, s, h, dh = t.shape
    return t.reshape(b, s // dil, dil, h, dh).transpose(0, 2, 1, 3, 4).reshape(b * dil, s // dil, h, dh)


def from_residues(t, dil, b):
    sub = t.shape[1]
    rest = t.shape[2:]
    t = t.reshape((b, dil, sub) + rest)
    t = jnp.moveaxis(t, 1, 2)
    return t.reshape((b, sub * dil) + rest)


def dilated_attention(q, k, v):
    b = q.shape[0]
    outs, lses = [], []
    for window, dil in DILATED_PATTERNS:
        o, lse = banded_attention(to_residues(q, dil)[:, :, :, None], to_residues(k, dil),
                                  to_residues(v, dil), window // dil)
        outs.append(from_residues(o[:, :, :, 0], dil, b))
        lses.append(from_residues(lse[..., 0], dil, b))
    wts = jax.nn.softmax(jnp.stack(lses), axis=0)
    return jnp.einsum('pbsh,pbshd->bshd', wts.astype(q.dtype), jnp.stack(outs))


def short_gated_conv(gate_b, gate_c, xb, w):
    s = xb.shape[1]
    u = gate_c * xb
    up = jnp.pad(u, ((0, 0), (CONV_K - 1, 0), (0, 0)))
    y = sum(w[i] * up[:, i:i + s] for i in range(CONV_K))
    return gate_b * y


def setup_inputs(seed: int = 0) -> dict:
    key = jax.random.key(seed)
    ks = jax.random.split(key, 12)
    nrm = jax.random.normal
    x = nrm(ks[0], (BATCH, SEQ, D_MODEL), jnp.float32)
    w_in = nrm(ks[1], (DEPTH, D_MODEL, IN_WIDTH), jnp.float32) * D_MODEL ** -0.5
    conv_w = nrm(ks[2], (DEPTH, CONV_K, CONV_CH), jnp.float32) * CONV_K ** -0.5
    sinks = nrm(ks[3], (DEPTH, C_KV_HEADS, C_GROUP), jnp.float32) * 0.5
    g_mix = 1.0 + 0.02 * nrm(ks[4], (DEPTH, D_MODEL), jnp.float32)
    g_group = 1.0 + 0.02 * nrm(ks[5], (DEPTH, MIX_WIDTH), jnp.float32)
    w_o = nrm(ks[6], (DEPTH, MIX_WIDTH, D_MODEL), jnp.float32) * MIX_WIDTH ** -0.5
    g_mlp = 1.0 + 0.02 * nrm(ks[7], (DEPTH, D_MODEL), jnp.float32)
    w_ff_in = nrm(ks[8], (DEPTH, D_MODEL, D_FF), jnp.float32) * D_MODEL ** -0.5
    w_ff_out = nrm(ks[9], (DEPTH, D_FF, D_MODEL), jnp.float32) * D_FF ** -0.5
    g_final = 1.0 + 0.02 * nrm(ks[10], (D_MODEL,), jnp.float32)
    return {"x": x, "w_in": w_in, "conv_w": conv_w, "sinks": sinks, "g_mix": g_mix,
            "g_group": g_group, "w_o": w_o, "g_mlp": g_mlp, "w_ff_in": w_ff_in,
            "w_ff_out": w_ff_out, "g_final": g_final}


def reference(x, w_in, conv_w, sinks, g_mix, g_group, w_o, g_mlp, w_ff_in, w_ff_out, g_final):
    b, s, _ = x.shape
    for l in range(DEPTH):
        h = rmsnorm(x, g_mix[l])
        z = jnp.einsum('bsd,de->bse', h, w_in[l])
        qa, ka, va, gb, gc, xb, qc, kc, vc = jnp.split(z, SPLIT_POINTS, axis=-1)
        ya = dilated_attention(qa.reshape(b, s, A_HEADS, HEAD_DIM),
                               ka.reshape(b, s, A_HEADS, HEAD_DIM),
                               va.reshape(b, s, A_HEADS, HEAD_DIM)).reshape(b, s, A_WIDTH)
        yb = short_gated_conv(gb, gc, xb, conv_w[l])
        oc, _ = banded_attention(qc.reshape(b, s, C_KV_HEADS, C_GROUP, HEAD_DIM),
                                 kc.reshape(b, s, C_KV_HEADS, HEAD_DIM),
                                 vc.reshape(b, s, C_KV_HEADS, HEAD_DIM),
                                 C_WINDOW - 1, sinks[l])
        yc = oc.reshape(b, s, C_WIDTH)
        y = jnp.concatenate([rms_normalize(ya), rms_normalize(yb), rms_normalize(yc)], axis=-1) * g_group[l]
        x = x + jnp.einsum('bse,ed->bsd', y, w_o[l])
        h2 = rmsnorm(x, g_mlp[l])
        a = jnp.square(jax.nn.relu(jnp.einsum('bsd,df->bsf', h2, w_ff_in[l])))
        x = x + jnp.einsum('bsf,fd->bsd', a, w_ff_out[l])
    return rmsnorm(x, g_final)
```

```cpp
#include <hip/hip_runtime.h>
#include <hip/hip_cooperative_groups.h>
#include <cstdio>
#include <cstdint>
namespace cg = cooperative_groups;
namespace pg8 {
#define PG8_LAS __attribute__((address_space(3)))
typedef unsigned short bf16_t;
typedef short bf16x8 __attribute__((ext_vector_type(8)));
typedef float f32x4 __attribute__((ext_vector_type(4)));
typedef unsigned u32x4 __attribute__((ext_vector_type(4)));
constexpr int BM = 256, BK = 64, HALF = 128, HTB = HALF * BK * 2  , STAGE_BYTES = 8 * HTB, NXCD = 8, WGM = 8;

__host__ __device__ __forceinline__ int lds_byte(int r, int c) { const int st = (r >> 4) * 2 + (c >> 5), rr = r & 15, cc = c & 31, ob = rr * 64 + cc * 2; return st * 1024 + (ob ^ (((ob >> 9) & 1) << 5)); }
__host__ __device__ __forceinline__ void stage_rc(int b, int& R, int& C) { const int st = b / 1024, sb = b % 1024, swz = sb ^ (((sb >> 9) & 1) << 5); R = (st >> 1) * 16 + swz / 64; C = (st & 1) * 32 + (swz % 64) / 2; }
__host__ __device__ __forceinline__ int perm32(int rho) { const int n = rho >> 4, i = rho & 15; return 8 * (i >> 2) + 4 * n + (i & 3); }

struct Unit { int pm, pn; };
struct Gemm { const bf16_t* A; const bf16_t* Bt; int M, N, K; };

struct StaticOrder {
    int nM, nN, nwg, G, c;
    __host__ __device__ void init(int M, int N, int G_, int c_) { nM = M / BM; nN = N / BM; nwg = nM * nN; G = G_; c = c_; }
    __host__ __device__ bool next(int i, Unit& u) const {
        const long L = (long)i * G + c; if (L >= nwg) return false;
        int wgid = (int)L; { const int q = nwg / NXCD, r = nwg % NXCD, xcd = wgid % NXCD, off = wgid / NXCD; wgid = (xcd < r ? xcd * (q + 1) : r * (q + 1) + (xcd - r) * q) + off; }
        const int nig = WGM * nN, gid = wgid / nig, fm = gid * WGM, gsz = (nM - fm) < WGM ? (nM - fm) : WGM;
        u.pm = fm + ((wgid % nig) % gsz); u.pn = (wgid % nig) / gsz; return true;
    }
    __device__ __forceinline__ void a_ready(const Unit&) const {}
    __device__ __forceinline__ void done(const Unit&) const {}
};
__device__ __forceinline__ unsigned cvt_pk_bf16(float lo, float hi) { unsigned r; asm volatile("v_cvt_pk_bf16_f32 %0, %1, %2" : "=v"(r) : "v"(lo), "v"(hi)); return r; }
typedef float f32x2 __attribute__((ext_vector_type(2)));
template <int ACT> struct EpiScale {
    static constexpr bool PERM = true, AFTER_DRAIN = false;
    bf16_t* O; int ldc; const float* ss; float inv_n, eps;
    __device__ __forceinline__ void operator()(const f32x4 (&acc)[2][2][4][2], const Unit& u, int wr, int wc, int fr, int fq) const {
        const int row0 = u.pm * BM + wr * 64 + fr; const int col0 = u.pn * BM + wc * 32 + 8 * fq;
#pragma unroll
        for (int ai = 0; ai < 2; ++ai)
#pragma unroll
            for (int m = 0; m < 4; ++m) { const int row = row0 + ai * HALF + m * 16; const float r = __builtin_amdgcn_rsqf(ss[row] * inv_n + eps);
                bf16_t* rowp = O + (size_t)row * ldc + col0;
#pragma unroll
                for (int bj = 0; bj < 2; ++bj) { f32x4 v0 = acc[ai][bj][m][0] * r, v1 = acc[ai][bj][m][1] * r;
                    if (ACT == 1) {
#pragma unroll
                        for (int e = 0; e < 4; ++e) { const float a = __builtin_fmaxf(v0[e], 0.f), b = __builtin_fmaxf(v1[e], 0.f); v0[e] = a * a; v1[e] = b * b; } }
                    u32x4 w; w.x = cvt_pk_bf16(v0[0], v0[1]); w.y = cvt_pk_bf16(v0[2], v0[3]); w.z = cvt_pk_bf16(v1[0], v1[1]); w.w = cvt_pk_bf16(v1[2], v1[3]);
                    *(u32x4*)(rowp + bj * HALF) = w; } }
    }
};
struct EpiResid {
    static constexpr bool PERM = true, AFTER_DRAIN = false;
    const float* base; float* out; bf16_t* xb; float* ss_out; int ldc;
    __device__ __forceinline__ void operator()(const f32x4 (&acc)[2][2][4][2], const Unit& u, int wr, int wc, int fr, int fq) const {
        const int row0 = u.pm * BM + wr * 64 + fr; const int col0 = u.pn * BM + wc * 32 + 8 * fq;
#pragma unroll
        for (int ai = 0; ai < 2; ++ai)
#pragma unroll
            for (int m = 0; m < 4; ++m) { const int row = row0 + ai * HALF + m * 16; const size_t off = (size_t)row * ldc + col0; float s = 0.f;
#pragma unroll
                for (int bj = 0; bj < 2; ++bj) { const f32x4 b0 = *(const f32x4*)(base + off + bj * HALF), b1 = *(const f32x4*)(base + off + bj * HALF + 4);
                    const f32x4 v0 = acc[ai][bj][m][0] + b0, v1 = acc[ai][bj][m][1] + b1;
                    *(f32x4*)(out + off + bj * HALF) = v0; *(f32x4*)(out + off + bj * HALF + 4) = v1;
                    u32x4 w; w.x = cvt_pk_bf16(v0[0], v0[1]); w.y = cvt_pk_bf16(v0[2], v0[3]); w.z = cvt_pk_bf16(v1[0], v1[1]); w.w = cvt_pk_bf16(v1[2], v1[3]);
                    *(u32x4*)(xb + off + bj * HALF) = w;
                    s += (v0[0] * v0[0] + v0[1] * v0[1]) + (v0[2] * v0[2] + v0[3] * v0[3]) + (v1[0] * v1[0] + v1[1] * v1[1]) + (v1[2] * v1[2] + v1[3] * v1[3]); }
                s += __shfl_xor(s, 16); s += __shfl_xor(s, 32);
                if (fq == 0) unsafeAtomicAdd(ss_out + row, s); }
    }
};
template <class Epi, class Sched, bool ALIGN_EPI = false, bool SP2 = false>
__device__ __forceinline__ void gemm_phase(PG8_LAS unsigned char* lds, const Gemm g, const Sched& S, const Epi& E) {
    int tid_ = threadIdx.x; asm volatile("" : "+v"(tid_));
    const int tid = tid_, wid = __builtin_amdgcn_readfirstlane(tid >> 6), lane = tid & 63, wr = wid >> 2, wc = wid & 3, fr = lane & 15, fq = lane >> 4;
    const int K = g.K, nt = K / BK;
    unsigned voffA[2], voffB[2];
#pragma unroll
    for (int i = 0; i < 2; ++i) { int R, C; stage_rc(tid * 16 + i * 8192, R, C); const int Rb = Epi::PERM ? ((R & ~31) + perm32(R & 31)) : R;
        voffA[i] = (unsigned)(R * K + C) * 2u; voffB[i] = (unsigned)(Rb * K + C) * 2u; }
    const size_t kstep = (size_t)(BK * 2);
    const size_t hstep = (size_t)HALF * K * 2;
    const size_t tstep = 2 * hstep;
    const unsigned ldsw = (unsigned)wid * 1024u;
    const int aoff = lds_byte(wr * 64 + fr, fq * 8), boff = lds_byte(wc * 32 + fr, fq * 8);
#define PG8_SA(b, h) (((b) * 2 + (h)) * HTB)
#define PG8_SB(b, h) ((4 + (b) * 2 + (h)) * HTB)
#define PG8_STAGE(bufoff, gbase, voff) do { _Pragma("unroll") for (int _i = 0; _i < 2; ++_i) \
        __builtin_amdgcn_global_load_lds((const unsigned*)((const char*)(gbase) + (voff)[_i]), (PG8_LAS unsigned*)(lds + (bufoff) + ldsw + _i * 8192), 16, 0, 0); } while (0)
#define PG8_LDA(dst, b, h) do { _Pragma("unroll") for (int m = 0; m < 4; ++m) _Pragma("unroll") for (int k = 0; k < 2; ++k) dst[m][k] = *(const PG8_LAS bf16x8*)(lds + PG8_SA(b, h) + aoff + m * 2048 + k * 1024); } while (0)
#define PG8_LDB(dst, b, h) do { _Pragma("unroll") for (int n = 0; n < 2; ++n) _Pragma("unroll") for (int k = 0; k < 2; ++k) dst[n][k] = *(const PG8_LAS bf16x8*)(lds + PG8_SB(b, h) + boff + n * 2048 + k * 1024); } while (0)
#define PG8_MMA(ai, bj, At, Bt) do { __builtin_amdgcn_s_setprio(1); _Pragma("unroll") for (int m = 0; m < 4; ++m) _Pragma("unroll") for (int n = 0; n < 2; ++n) _Pragma("unroll") for (int k = 0; k < 2; ++k) \
        acc[ai][bj][m][n] = __builtin_amdgcn_mfma_f32_16x16x32_bf16(Bt[n][k], At[m][k], acc[ai][bj][m][n], 0, 0, 0); __builtin_amdgcn_s_setprio(0); } while (0)
#define PG8_WAIT_V(n) asm volatile("s_waitcnt vmcnt(" #n ")" ::: "memory")
#define PG8_WAIT_L(n) asm volatile("s_waitcnt lgkmcnt(" #n ")" ::: "memory")
#define PG8_BAR __builtin_amdgcn_s_barrier()
#define PG8_SCHED __builtin_amdgcn_sched_barrier(0)
    Unit cur, nxt; int ui = 0;
    if (!S.next(0, cur)) return;
    f32x4 acc[2][2][4][2];
#pragma unroll
    for (int a = 0; a < 2; ++a)
#pragma unroll
        for (int b = 0; b < 2; ++b)
#pragma unroll
            for (int m = 0; m < 4; ++m)
#pragma unroll
                for (int n = 0; n < 2; ++n) acc[a][b][m][n] = (f32x4){0.f, 0.f, 0.f, 0.f};
    bf16x8 At[4][2], B0[2][2], B1[2][2];
    const char* cA = (const char*)g.A + (size_t)cur.pm * tstep; const char* cB = (const char*)g.Bt + (size_t)cur.pn * tstep;
    S.a_ready(cur);
    if constexpr (SP2) {
        PG8_STAGE(PG8_SB(0, 0), cB, voffB); PG8_STAGE(PG8_SB(0, 1), cB + hstep, voffB); PG8_STAGE(PG8_SA(0, 0), cA, voffA); PG8_STAGE(PG8_SA(0, 1), cA + hstep, voffA);
        if (wr == 1) PG8_BAR;
        PG8_WAIT_V(2); PG8_BAR;
        PG8_STAGE(PG8_SB(1, 0), cB + kstep, voffB); PG8_STAGE(PG8_SA(1, 0), cA + kstep, voffA); PG8_STAGE(PG8_SB(1, 1), cB + hstep + kstep, voffB);
        PG8_WAIT_V(6); PG8_BAR;
    } else {
        PG8_STAGE(PG8_SB(0, 0), cB, voffB); PG8_STAGE(PG8_SA(0, 0), cA, voffA); PG8_STAGE(PG8_SB(0, 1), cB + hstep, voffB); PG8_STAGE(PG8_SA(0, 1), cA + hstep, voffA);
        if (wr == 1) PG8_BAR;
        PG8_WAIT_V(4); PG8_BAR;
        PG8_STAGE(PG8_SB(1, 0), cB + kstep, voffB); PG8_STAGE(PG8_SA(1, 0), cA + kstep, voffA); PG8_STAGE(PG8_SB(1, 1), cB + hstep + kstep, voffB);
        PG8_WAIT_V(6); PG8_BAR;
    }
    for (;;) {
        const bool has_next = S.next(ui + 1, nxt);
        const char* nA = has_next ? (const char*)g.A + (size_t)nxt.pm * tstep : cA; const char* nB = has_next ? (const char*)g.Bt + (size_t)nxt.pn * tstep : cB;
        for (int t = 0; t < nt; t += 2) {
            const bool last = (t == nt - 2);
            const char* a1 = cA + (size_t)(t + 1) * kstep;
            const char* a2 = last ? nA : cA + (size_t)(t + 2) * kstep; const char* b2 = last ? nB : cB + (size_t)(t + 2) * kstep;
            const char* a3 = a2 + kstep; const char* b3 = b2 + kstep;
            if (last && has_next) S.a_ready(nxt);
            if constexpr (SP2) {
            PG8_LDB(B0, 0, 0); PG8_LDB(B1, 0, 1); PG8_SCHED; PG8_LDA(At, 0, 0); PG8_STAGE(PG8_SA(1, 1), a1 + hstep, voffA);
            PG8_WAIT_V(8); PG8_WAIT_L(0); PG8_BAR; PG8_MMA(0, 0, At, B0); PG8_MMA(0, 1, At, B1); PG8_BAR; PG8_SCHED;
            PG8_LDA(At, 0, 1); PG8_STAGE(PG8_SB(0, 0), b2, voffB); PG8_STAGE(PG8_SB(0, 1), b2 + hstep, voffB); PG8_STAGE(PG8_SA(0, 0), a2, voffA);
            PG8_WAIT_V(8); PG8_WAIT_L(0); PG8_BAR; PG8_MMA(1, 0, At, B0); PG8_MMA(1, 1, At, B1); PG8_BAR; PG8_SCHED;
            PG8_LDB(B0, 1, 0); PG8_LDB(B1, 1, 1); PG8_SCHED; PG8_LDA(At, 1, 0); PG8_STAGE(PG8_SA(0, 1), a2 + hstep, voffA);
            PG8_WAIT_V(8); PG8_WAIT_L(0); PG8_BAR; PG8_MMA(0, 0, At, B0); PG8_MMA(0, 1, At, B1); PG8_BAR; PG8_SCHED;
            PG8_LDA(At, 1, 1); PG8_STAGE(PG8_SB(1, 0), b3, voffB); PG8_STAGE(PG8_SB(1, 1), b3 + hstep, voffB); PG8_STAGE(PG8_SA(1, 0), a3, voffA);
            PG8_WAIT_V(8); PG8_WAIT_L(0); PG8_BAR; PG8_MMA(1, 0, At, B0); PG8_MMA(1, 1, At, B1); PG8_BAR; PG8_SCHED;
            } else {
            PG8_LDB(B0, 0, 0); PG8_SCHED; PG8_LDA(At, 0, 0); PG8_STAGE(PG8_SA(1, 1), a1 + hstep, voffA);
            PG8_WAIT_L(8); PG8_BAR; PG8_WAIT_L(0); PG8_MMA(0, 0, At, B0); PG8_BAR; PG8_SCHED;
            PG8_LDB(B1, 0, 1); PG8_STAGE(PG8_SB(0, 0), b2, voffB);
            PG8_BAR; PG8_WAIT_L(0); PG8_MMA(0, 1, At, B1); PG8_BAR;
            PG8_LDA(At, 0, 1); PG8_STAGE(PG8_SA(0, 0), a2, voffA);
            PG8_BAR; PG8_WAIT_L(0); PG8_MMA(1, 0, At, B0); PG8_BAR; PG8_SCHED;
            PG8_STAGE(PG8_SB(0, 1), b2 + hstep, voffB);
            PG8_WAIT_V(6); PG8_BAR; PG8_MMA(1, 1, At, B1); PG8_BAR;
            PG8_LDB(B0, 1, 0); PG8_SCHED; PG8_LDA(At, 1, 0); PG8_STAGE(PG8_SA(0, 1), a2 + hstep, voffA);
            PG8_WAIT_L(8); PG8_BAR; PG8_WAIT_L(0); PG8_MMA(0, 0, At, B0); PG8_BAR; PG8_SCHED;
            PG8_LDB(B1, 1, 1); PG8_STAGE(PG8_SB(1, 0), b3, voffB);
            PG8_BAR; PG8_WAIT_L(0); PG8_MMA(0, 1, At, B1); PG8_BAR;
            PG8_LDA(At, 1, 1); PG8_STAGE(PG8_SA(1, 0), a3, voffA);
            PG8_BAR; PG8_WAIT_L(0); PG8_MMA(1, 0, At, B0); PG8_BAR; PG8_SCHED;
            PG8_STAGE(PG8_SB(1, 1), b3 + hstep, voffB);
            PG8_WAIT_V(6); PG8_BAR; PG8_MMA(1, 1, At, B1); PG8_BAR;
            }
        }
        if constexpr (ALIGN_EPI) { if (wr == 0) PG8_BAR; }
        if constexpr (!Epi::AFTER_DRAIN) { E(acc, cur, wr, wc, fr, fq); S.done(cur); }
        if (!has_next) break;
#pragma unroll
        for (int a = 0; a < 2; ++a)
#pragma unroll
            for (int b = 0; b < 2; ++b)
#pragma unroll
                for (int m = 0; m < 4; ++m)
#pragma unroll
                    for (int n = 0; n < 2; ++n) acc[a][b][m][n] = (f32x4){0.f, 0.f, 0.f, 0.f};
        cur = nxt; cA = nA; cB = nB; ++ui;
        if constexpr (ALIGN_EPI) { if (wr == 1) PG8_BAR; }
    }
    PG8_WAIT_V(0);
    if constexpr (!ALIGN_EPI) { if (wr == 0) PG8_BAR; }
    PG8_BAR;
    if constexpr (Epi::AFTER_DRAIN) { E.fused(acc, cur, wr, wc, fr, fq, lds, wid, lane); S.done(cur); }
#undef PG8_SA
#undef PG8_SB
#undef PG8_STAGE
#undef PG8_LDA
#undef PG8_LDB
#undef PG8_MMA
#undef PG8_WAIT_V
#undef PG8_WAIT_L
#undef PG8_BAR
#undef PG8_SCHED
}
}
namespace att {
typedef unsigned short bf16_t;
typedef short bf16x8 __attribute__((ext_vector_type(8)));
typedef short s16x4 __attribute__((ext_vector_type(4)));
typedef float f32x16 __attribute__((ext_vector_type(16)));
typedef unsigned u32x4 __attribute__((ext_vector_type(4)));
#define ALAS __attribute__((address_space(3)))
constexpr int ZP = 2560;
constexpr int KCS = 6160;
constexpr int VDH = 24576;
constexpr int LDS_K = 0, LDS_V = 8 * KCS  , LDS_WS = LDS_V + 2 * VDH  , LDS_OST = LDS_WS + 8 * 256  , LDS_END = LDS_OST + 8 * 4096;
__device__ __forceinline__ int crow(int r, int hi) { return (r & 3) + 8 * (r >> 2) + 4 * hi; }
__device__ __forceinline__ unsigned cvtpk(float lo, float hi) { unsigned r; asm volatile("v_cvt_pk_bf16_f32 %0, %1, %2" : "=v"(r) : "v"(lo), "v"(hi)); return r; }
__device__ __forceinline__ float swapmax(float m) { auto rr = __builtin_amdgcn_permlane32_swap(__float_as_uint(m), __float_as_uint(m), false, false); return __builtin_fmaxf(__uint_as_float(rr[0]), __uint_as_float(rr[1])); }
__device__ __forceinline__ float swapsum(float m) { auto rr = __builtin_amdgcn_permlane32_swap(__float_as_uint(m), __float_as_uint(m), false, false); return __uint_as_float(rr[0]) + __uint_as_float(rr[1]); }
template <int OFF> __device__ __forceinline__ void pv32(f32x16* o, int vb, bf16x8 pa0, bf16x8 pa1) {
#pragma unroll
    for (int d0 = 0; d0 < 2; ++d0) { s16x4 lo[2], hi[2];
#pragma unroll
        for (int ks = 0; ks < 2; ++ks) {
            asm volatile("ds_read_b64_tr_b16 %0,%1 offset:%c2" : "=&v"(lo[ks]) : "v"(vb), "i"(d0 * VDH + OFF + ks * 1024) : "memory");
            asm volatile("ds_read_b64_tr_b16 %0,%1 offset:%c2" : "=&v"(hi[ks]) : "v"(vb), "i"(d0 * VDH + OFF + ks * 1024 + 512) : "memory"); }
        asm volatile("s_waitcnt lgkmcnt(0)" ::: "memory"); __builtin_amdgcn_sched_barrier(0);
#define PK(k) (bf16x8){lo[k][0], lo[k][1], lo[k][2], lo[k][3], hi[k][0], hi[k][1], hi[k][2], hi[k][3]}
        o[d0] = __builtin_amdgcn_mfma_f32_32x32x16_bf16(pa0, PK(0), o[d0], 0, 0, 0);
        o[d0] = __builtin_amdgcn_mfma_f32_32x32x16_bf16(pa1, PK(1), o[d0], 0, 0, 0);
#undef PK
    }
}
__device__ __forceinline__ void attn_unit(int kind, int b, int h, int idx16, const bf16_t* __restrict__ Z, bf16_t* __restrict__ O, float* __restrict__ LSE, float sink2, char* shm) {
    int tid_ = threadIdx.x; asm volatile("" : "+v"(tid_));
    const int tid = tid_, lane = tid & 63, r32 = lane & 31, hi = lane >> 5; const int wid = __builtin_amdgcn_readfirstlane(tid >> 6);
    const int lg = (kind == 1) ? 2 : (kind == 2) ? 4 : 0; const int dil = 1 << lg;
    const int res = idx16 & (dil - 1), qb = idx16 >> lg, q0 = qb * 256;
    const int qcol = (kind < 3 ? 0 : 1920) + h * 64;
    const int kcol = (kind < 3) ? 384 + h * 64 : 2304 + (h / 3) * 64;
    const int vcol = (kind < 3) ? 768 + h * 64 : 2432 + (h / 3) * 64;
    const long rowb = (long)b * 4096 + res;
    ALAS char* sh = (ALAS char*)shm;
#pragma unroll
    for (int j = 0; j < 6; ++j) { const int i = tid + 512 * j, kk = i >> 3, c8 = i & 7, kpos = q0 - 128 + kk;
        u32x4 kv = (u32x4){0u, 0u, 0u, 0u}, vv = (u32x4){0u, 0u, 0u, 0u};
        if (kpos >= 0) { const bf16_t* rp = Z + (rowb + (long)dil * kpos) * ZP; kv = *(const u32x4*)(rp + kcol + c8 * 8); vv = *(const u32x4*)(rp + vcol + c8 * 8); }
        *(ALAS u32x4*)(sh + LDS_K + c8 * KCS + kk * 16) = kv;
        *(ALAS u32x4*)(sh + LDS_V + (c8 >> 2) * VDH + (kk >> 4) * 1024 + (kk & 15) * 64 + (c8 & 3) * 16) = vv; }
    const long rowq = rowb + (long)dil * (q0 + 32 * wid + r32);
    bf16x8 qr[4];
#pragma unroll
    for (int d0 = 0; d0 < 4; ++d0) qr[d0] = *(const bf16x8*)(Z + rowq * ZP + qcol + d0 * 16 + hi * 8);
    __syncthreads();
    f32x16 p[5];
    { ALAS const char* kb = sh + LDS_K + hi * KCS + (32 * wid + r32) * 16;
#pragma unroll
      for (int blk = 0; blk < 5; ++blk) {
#pragma unroll
        for (int d0 = 0; d0 < 4; ++d0) { const bf16x8 a = *(ALAS const bf16x8*)(kb + d0 * 2 * KCS + blk * 512);
            if (d0 == 0) { f32x16 z = {}; p[blk] = __builtin_amdgcn_mfma_f32_32x32x16_bf16(a, qr[0], z, 0, 0, 0); }
            else p[blk] = __builtin_amdgcn_mfma_f32_32x32x16_bf16(a, qr[d0], p[blk], 0, 0, 0); } } }
    const float NEG = -INFINITY; const int lo_thr = r32 + (kind == 3 ? 1 : 0);
#pragma unroll
    for (int r = 0; r < 16; ++r) { const int cr = crow(r, hi); if (cr < lo_thr) p[0][r] = NEG; if (cr > r32) p[4][r] = NEG; }
    if (qb == 0) {
#pragma unroll
        for (int blk = 0; blk < 4; ++blk) if (wid + blk < 4) {
#pragma unroll
            for (int r = 0; r < 16; ++r) p[blk][r] = NEG; } }
    float m = p[4][0];
#pragma unroll
    for (int blk = 0; blk < 5; ++blk)
#pragma unroll
        for (int r = 0; r < 16; ++r) m = __builtin_fmaxf(m, p[blk][r]);
    m = swapmax(m);
    if (kind == 3) m = __builtin_fmaxf(m, sink2);
    float l = 0.f;
#pragma unroll
    for (int blk = 0; blk < 5; ++blk)
#pragma unroll
        for (int r = 0; r < 16; ++r) { const float e = __builtin_amdgcn_exp2f(p[blk][r] - m); p[blk][r] = e; l += e; }
    l = swapsum(l);
    if (kind == 3) l += __builtin_amdgcn_exp2f(sink2 - m);
    f32x16 o[2]; o[0] = f32x16{}; o[1] = f32x16{};
    const int vb = (int)(unsigned)(uintptr_t)(shm + LDS_V) + (2 * wid) * 1024 + ((lane >> 4) & 1) * 32 + (lane & 3) * 8 + (4 * hi + ((lane & 15) >> 2)) * 64;
#define PA(P, B) __builtin_bit_cast(bf16x8, (u32x4){cvtpk(P[B], P[B + 1]), cvtpk(P[B + 2], P[B + 3]), cvtpk(P[B + 4], P[B + 5]), cvtpk(P[B + 6], P[B + 7])})
    { const bf16x8 a0 = PA(p[0], 0), a1 = PA(p[0], 8); pv32<0 * 2048>(o, vb, a0, a1); }
    { const bf16x8 a0 = PA(p[1], 0), a1 = PA(p[1], 8); pv32<1 * 2048>(o, vb, a0, a1); }
    { const bf16x8 a0 = PA(p[2], 0), a1 = PA(p[2], 8); pv32<2 * 2048>(o, vb, a0, a1); }
    { const bf16x8 a0 = PA(p[3], 0), a1 = PA(p[3], 8); pv32<3 * 2048>(o, vb, a0, a1); }
    { const bf16x8 a0 = PA(p[4], 0), a1 = PA(p[4], 8); pv32<4 * 2048>(o, vb, a0, a1); }
#undef PA
    ALAS float* wsf = (ALAS float*)(sh + LDS_WS) + wid * 64;
    if (hi == 0) { wsf[32 + r32] = l; if (LSE) LSE[rowq * 6 + h] = m + __builtin_amdgcn_logf(l); }
    asm volatile("s_waitcnt lgkmcnt(0)" ::: "memory");
    float rli[16];
#pragma unroll
    for (int r = 0; r < 16; ++r) rli[r] = __builtin_amdgcn_rcpf(wsf[32 + crow(r, hi)]);
    { ALAS bf16_t* stg = (ALAS bf16_t*)(sh + LDS_OST) + wid * 2048;
#pragma unroll
      for (int r = 0; r < 16; ++r) { const int orow = crow(r, hi);
#pragma unroll
        for (int d0 = 0; d0 < 2; ++d0) stg[orow * 64 + d0 * 32 + r32] = (bf16_t)(cvtpk(o[d0][r] * rli[r], 0.f) & 0xffffu); }
      asm volatile("s_waitcnt lgkmcnt(0)" ::: "memory");
#pragma unroll
      for (int i = 0; i < 4; ++i) { const int row = i * 8 + (lane >> 3), ch = lane & 7; const u32x4 v = *(ALAS const u32x4*)(stg + row * 64 + ch * 8);
          const long trow = rowb + (long)dil * (q0 + 32 * wid + row); *(u32x4*)(O + trow * 384 + h * 64 + ch * 8) = v; } }
    __syncthreads();
}
#undef ALAS
}
constexpr int NWAVES = 8;
constexpr int T_ROWS = 8 * 4096, DM = 1024, INW = 2560, FF = 4096, DEPTH = 2;
constexpr float EPS = 1e-6f;
constexpr float C2 = 0.125f * 1.4426950408889634f;
constexpr size_t MiB = 1u << 20;
constexpr size_t WS_SS = 0;
constexpr size_t WS_W = 1 * MiB;
constexpr size_t W_LAYER = 23 * MiB, W_IN = 0, W_O = 5 * MiB, W_1 = 7 * MiB, W_2 = 15 * MiB;
constexpr size_t WS_XB = 48 * MiB;
constexpr size_t WS_Y = 112 * MiB;
constexpr size_t WS_LSE = 176 * MiB;
constexpr size_t WS_Z = 180 * MiB;
constexpr size_t WS_OA = 340 * MiB;
constexpr size_t WS_OC = 412 * MiB;
constexpr size_t WS_H = 180 * MiB;
constexpr size_t WS_END = 436 * MiB;
constexpr int LDS_BYTES = 147456;

#define GAS __attribute__((address_space(1)))
#define LAS __attribute__((address_space(3)))
typedef unsigned short bf16;
typedef unsigned v4u __attribute__((ext_vector_type(4)));
typedef unsigned v2u __attribute__((ext_vector_type(2)));
typedef float f32x4 __attribute__((ext_vector_type(4)));
__device__ __forceinline__ unsigned pk2(float lo, float hi) { unsigned r; asm volatile("v_cvt_pk_bf16_f32 %0, %1, %2" : "=v"(r) : "v"(lo), "v"(hi)); return r; }
__device__ __forceinline__ float bflo(unsigned u) { return __uint_as_float(u << 16); }
__device__ __forceinline__ float bfhi(unsigned u) { return __uint_as_float(u & 0xffff0000u); }
__device__ __forceinline__ float wave_sum(float v) {
#pragma unroll
    for (int o = 1; o < 64; o <<= 1) v += __shfl_xor(v, o);
    return v;
}
__device__ __forceinline__ void transpose_item(const float* W, int K, int N, bf16* WT, LAS float* scr, int item, int lane, const float* gk, bool qmode) {
    const int nblk = N / 32, kb = item / nblk, nb = item % nblk, k0 = 64 * kb, n0 = 32 * nb;
    const float cs = (qmode && (n0 < 384 || (n0 >= 1920 && n0 < 2304))) ? C2 : 1.0f;
#pragma unroll 8
    for (int i = 0; i < 32; ++i) { const int kk = 2 * i + (lane >> 5); const float g = gk ? gk[k0 + kk] * cs : cs; scr[kk * 33 + (lane & 31)] = W[(size_t)(k0 + kk) * N + n0 + (lane & 31)] * g; }
    asm volatile("s_waitcnt lgkmcnt(0)" ::: "memory");
    const int c = lane & 7;
#pragma unroll
    for (int j = 0; j < 4; ++j) { const int n = (lane >> 3) + 8 * j; const LAS float* s = scr + (8 * c) * 33 + n;
        v4u o; o.x = pk2(s[0 * 33], s[1 * 33]); o.y = pk2(s[2 * 33], s[3 * 33]); o.z = pk2(s[4 * 33], s[5 * 33]); o.w = pk2(s[6 * 33], s[7 * 33]);
        *(v4u*)(WT + (size_t)(n0 + n) * K + k0 + 8 * c) = o; }
    asm volatile("s_waitcnt lgkmcnt(0)" ::: "memory");
}

struct Args { const float* in[11]; float* out; unsigned char* ws; int ph_lo, ph_hi; };
constexpr int N_PHASES = 14;

__global__ void __launch_bounds__(NWAVES * 64, 2) hymba_fwd(Args args) {
    extern __shared__ __attribute__((aligned(16))) unsigned char lds[];
    cg::grid_group grid = cg::this_grid();
    const int tid = threadIdx.x, lane = tid & 63, wave = __builtin_amdgcn_readfirstlane(tid >> 6);
    const int G = gridDim.x, gw = blockIdx.x * NWAVES + wave, NGW = G * NWAVES;
    unsigned char* ws = args.ws;
    const float* x_in = args.in[0]; const float* w_in = args.in[1]; const float* conv_w = args.in[2]; const float* sinks = args.in[3];
    const float* g_mix = args.in[4]; const float* g_group = args.in[5]; const float* w_o = args.in[6]; const float* g_mlp = args.in[7];
    const float* w_ff_in = args.in[8]; const float* w_ff_out = args.in[9]; const float* g_final = args.in[10];
    float* out = args.out;
    float* SS = (float*)(ws + WS_SS);
    bf16* XB = (bf16*)(ws + WS_XB); bf16* Y = (bf16*)(ws + WS_Y); float* LSE = (float*)(ws + WS_LSE); bf16* Z = (bf16*)(ws + WS_Z);
    bf16* OA = (bf16*)(ws + WS_OA); bf16* OC = (bf16*)(ws + WS_OC); bf16* HB = (bf16*)(ws + WS_H);
    const int lo = args.ph_lo, hi = args.ph_hi;
#define IN(k) (lo <= (k) && (k) < hi)
#define SEAM(k) do { if (IN(k) && IN((k) + 1)) grid.sync(); } while (0)

    if (IN(0)) {
        LAS float* scr = (LAS float*)((LAS unsigned char*)lds + wave * 16384);
        constexpr int I_IN = (DM / 64) * (INW / 32), I_O = (DM / 64) * (DM / 32), I_1 = (DM / 64) * (FF / 32), I_2 = (FF / 64) * (DM / 32), I_L = I_IN + I_O + I_1 + I_2;
        for (int it = gw; it < DEPTH * I_L; it += NGW) {
            const int l = it / I_L; int r = it % I_L; bf16* wb = (bf16*)(ws + WS_W + l * W_LAYER);
            if (r < I_IN) { transpose_item(w_in + (size_t)l * DM * INW, DM, INW, (bf16*)((unsigned char*)wb + W_IN), scr, r, lane, g_mix + l * DM, true); continue; } r -= I_IN;
            if (r < I_O) { transpose_item(w_o + (size_t)l * DM * DM, DM, DM, (bf16*)((unsigned char*)wb + W_O), scr, r, lane, g_group + l * DM, false); continue; } r -= I_O;
            if (r < I_1) { transpose_item(w_ff_in + (size_t)l * DM * FF, DM, FF, (bf16*)((unsigned char*)wb + W_1), scr, r, lane, g_mlp + l * DM, false); continue; } r -= I_1;
            transpose_item(w_ff_out + (size_t)l * FF * DM, FF, DM, (bf16*)((unsigned char*)wb + W_2), scr, r, lane, nullptr, false);
        }
        for (int m = gw; m < T_ROWS; m += NGW) {
            const f32x4* xr = (const f32x4*)(x_in + (size_t)m * DM) + lane; f32x4 v[4]; float s = 0.f;
#pragma unroll
            for (int j = 0; j < 4; ++j) { v[j] = xr[64 * j]; s += (v[j].x * v[j].x + v[j].y * v[j].y) + (v[j].z * v[j].z + v[j].w * v[j].w); }
            s = wave_sum(s);
            v2u* o8 = (v2u*)(XB + (size_t)m * DM) + lane;
#pragma unroll
            for (int j = 0; j < 4; ++j) { v2u w; w.x = pk2(v[j].x, v[j].y); w.y = pk2(v[j].z, v[j].w); o8[64 * j] = w; }
            if (lane == 0) SS[m] = s;
        }
        for (int i = blockIdx.x * 512 + tid; i < 4 * T_ROWS; i += G * 512) SS[T_ROWS + i] = 0.f;
    }
    SEAM(0);

    for (int l = 0; l < DEPTH; ++l) {
        const int pb = 1 + 6 * l;
        unsigned char* wl = ws + WS_W + l * W_LAYER;
        if (IN(pb)) {
            pg8::Gemm g{XB, (const bf16*)(wl + W_IN), T_ROWS, INW, DM}; pg8::StaticOrder S; S.init(T_ROWS, INW, G, (int)blockIdx.x);
            pg8::EpiScale<0> E{Z, INW, SS + (size_t)(2 * l) * T_ROWS, 1.0f / DM, EPS};
            pg8::gemm_phase<pg8::EpiScale<0>, pg8::StaticOrder, true, true>((LAS unsigned char*)lds, g, S, E);
        }
        SEAM(pb);
        if (IN(pb + 1)) {
            for (int u = blockIdx.x; u < 3072; u += G) {
                const int idx16 = u & 15, hh = (u >> 4) % 6, kb = u / 96, kind = kb & 3, b = kb >> 2;
                bf16* O = (kind < 3) ? OA + (size_t)kind * T_ROWS * 384 : OC;
                float* L = (kind < 3) ? LSE + (size_t)kind * T_ROWS * 6 : nullptr;
                const float sink2 = (kind == 3) ? sinks[l * 6 + hh] * 1.4426950408889634f : 0.f;
                att::attn_unit(kind, b, hh, idx16, Z, O, L, sink2, (char*)lds);
            }
        }
        SEAM(pb + 1);
        if (IN(pb + 2)) {
            const float* cw = conv_w + l * 768;
            for (int m = gw; m < T_ROWS; m += NGW) {
                const int s = m & 4095; const bf16* zr = Z + (size_t)m * INW;
                float ya[6], yc[6]; float ssA = 0.f, ssC = 0.f;
#pragma unroll
                for (int j = 0; j < 3; ++j) { const int col = 128 * j + 2 * lane, hd = 2 * j + (lane >> 5);
                    const float l0 = LSE[(size_t)m * 6 + hd], l1 = LSE[(size_t)(T_ROWS + m) * 6 + hd], l2 = LSE[(size_t)(2 * T_ROWS + m) * 6 + hd];
                    const float mx = __builtin_fmaxf(__builtin_fmaxf(l0, l1), l2);
                    float w0 = __builtin_amdgcn_exp2f(l0 - mx), w1 = __builtin_amdgcn_exp2f(l1 - mx), w2 = __builtin_amdgcn_exp2f(l2 - mx);
                    const float inv = 1.0f / (w0 + w1 + w2); w0 *= inv; w1 *= inv; w2 *= inv;
                    const unsigned a0 = *(const unsigned*)(OA + (size_t)m * 384 + col), a1 = *(const unsigned*)(OA + (size_t)(T_ROWS + m) * 384 + col), a2 = *(const unsigned*)(OA + (size_t)(2 * T_ROWS + m) * 384 + col);
                    ya[2 * j] = w0 * bflo(a0) + w1 * bflo(a1) + w2 * bflo(a2); ya[2 * j + 1] = w0 * bfhi(a0) + w1 * bfhi(a1) + w2 * bfhi(a2);
                    const unsigned c0 = *(const unsigned*)(OC + (size_t)m * 384 + col); yc[2 * j] = bflo(c0); yc[2 * j + 1] = bfhi(c0);
                    ssA += ya[2 * j] * ya[2 * j] + ya[2 * j + 1] * ya[2 * j + 1]; ssC += yc[2 * j] * yc[2 * j] + yc[2 * j + 1] * yc[2 * j + 1]; }
                const int ch = 4 * lane; float u3[3][4];
#pragma unroll
                for (int dt = 0; dt < 3; ++dt) { v2u gc = (v2u){0u, 0u}, xv = (v2u){0u, 0u};
                    if (s - dt >= 0) { gc = *(const v2u*)(zr - (size_t)dt * INW + 1408 + ch); xv = *(const v2u*)(zr - (size_t)dt * INW + 1664 + ch); }
                    u3[dt][0] = bflo(gc.x) * bflo(xv.x); u3[dt][1] = bfhi(gc.x) * bfhi(xv.x); u3[dt][2] = bflo(gc.y) * bflo(xv.y); u3[dt][3] = bfhi(gc.y) * bfhi(xv.y); }
                const v2u gbv = *(const v2u*)(zr + 1152 + ch); const float gb[4] = {bflo(gbv.x), bfhi(gbv.x), bflo(gbv.y), bfhi(gbv.y)};
                const f32x4 cw0 = *(const f32x4*)(cw + ch), cw1 = *(const f32x4*)(cw + 256 + ch), cw2 = *(const f32x4*)(cw + 512 + ch);
                float yb[4]; float ssB = 0.f;
#pragma unroll
                for (int e = 0; e < 4; ++e) { yb[e] = gb[e] * (cw0[e] * u3[2][e] + cw1[e] * u3[1][e] + cw2[e] * u3[0][e]); ssB += yb[e] * yb[e]; }
                ssA = wave_sum(ssA); ssB = wave_sum(ssB); ssC = wave_sum(ssC);
                const float rA = __builtin_amdgcn_rsqf(ssA * (1.0f / 384.0f) + EPS), rB = __builtin_amdgcn_rsqf(ssB * (1.0f / 256.0f) + EPS), rC = __builtin_amdgcn_rsqf(ssC * (1.0f / 384.0f) + EPS);
                bf16* yr = Y + (size_t)m * DM;
#pragma unroll
                for (int j = 0; j < 3; ++j) { const int col = 128 * j + 2 * lane;
                    *(unsigned*)(yr + col) = pk2(ya[2 * j] * rA, ya[2 * j + 1] * rA); *(unsigned*)(yr + 640 + col) = pk2(yc[2 * j] * rC, yc[2 * j + 1] * rC); }
                v2u wb; wb.x = pk2(yb[0] * rB, yb[1] * rB); wb.y = pk2(yb[2] * rB, yb[3] * rB); *(v2u*)(yr + 384 + ch) = wb;
            }
        }
        SEAM(pb + 2);
        if (IN(pb + 3)) {
            pg8::Gemm g{Y, (const bf16*)(wl + W_O), T_ROWS, DM, DM}; pg8::StaticOrder S; S.init(T_ROWS, DM, G, (int)blockIdx.x);
            pg8::EpiResid E{l == 0 ? x_in : (const float*)out, out, XB, SS + (size_t)(2 * l + 1) * T_ROWS, DM};
            pg8::gemm_phase<pg8::EpiResid, pg8::StaticOrder, true, true>((LAS unsigned char*)lds, g, S, E);
        }
        SEAM(pb + 3);
        if (IN(pb + 4)) {
            pg8::Gemm g{XB, (const bf16*)(wl + W_1), T_ROWS, FF, DM}; pg8::StaticOrder S; S.init(T_ROWS, FF, G, (int)blockIdx.x);
            pg8::EpiScale<1> E{HB, FF, SS + (size_t)(2 * l + 1) * T_ROWS, 1.0f / DM, EPS};
            pg8::gemm_phase<pg8::EpiScale<1>, pg8::StaticOrder, true, true>((LAS unsigned char*)lds, g, S, E);
        }
        SEAM(pb + 4);
        if (IN(pb + 5)) {
            pg8::Gemm g{HB, (const bf16*)(wl + W_2), T_ROWS, DM, FF}; pg8::StaticOrder S; S.init(T_ROWS, DM, G, (int)blockIdx.x);
            pg8::EpiResid E{(const float*)out, out, XB, SS + (size_t)(2 * l + 2) * T_ROWS, DM};
            pg8::gemm_phase<pg8::EpiResid, pg8::StaticOrder, true, true>((LAS unsigned char*)lds, g, S, E);
        }
        SEAM(pb + 5);
    }
    if (IN(13)) {
        const float* ssf = SS + (size_t)4 * T_ROWS;
        for (int m = gw; m < T_ROWS; m += NGW) {
            const float r = __builtin_amdgcn_rsqf(ssf[m] * (1.0f / DM) + EPS);
            f32x4* xr = (f32x4*)(out + (size_t)m * DM) + lane; const f32x4* gr = (const f32x4*)g_final + lane;
#pragma unroll
            for (int j = 0; j < 4; ++j) { const f32x4 v = xr[64 * j], g = gr[64 * j]; xr[64 * j] = v * r * g; }
        }
    }
#undef IN
#undef SEAM
}

#ifndef MK_N_LAUNCHES
#define MK_N_LAUNCHES 14
#endif
extern "C" void kernel_launch(void* const* d_in, const int* in_sizes, int n_in, void* d_out, int out_size, void* d_ws, size_t ws_size, hipStream_t stream) {
    static int grid = 0;
    if (grid == 0) {
        if (n_in != 11 || out_size != T_ROWS * DM || ws_size < WS_END) { fprintf(stderr, "kernel_launch: unexpected shapes (n_in %d out %d ws %zu)\n", n_in, out_size, ws_size); grid = -1; return; }
        int dev = 0, cus = 0, per_cu = 0;
        hipGetDevice(&dev); hipDeviceGetAttribute(&cus, hipDeviceAttributeMultiprocessorCount, dev);
        hipFuncSetAttribute((const void*)hymba_fwd, hipFuncAttributeMaxDynamicSharedMemorySize, LDS_BYTES);
        hipOccupancyMaxActiveBlocksPerMultiprocessor(&per_cu, (const void*)hymba_fwd, NWAVES * 64, LDS_BYTES);
        if (per_cu < 1) per_cu = 1;
        (void)hipGetLastError();
        grid = cus * per_cu;
    }
    if (grid < 0) return;
    Args a{};
    for (int i = 0; i < 11; ++i) a.in[i] = (const float*)d_in[i];
    a.out = (float*)d_out; a.ws = (unsigned char*)d_ws;
    if (MK_N_LAUNCHES == 1) {
        a.ph_lo = 0; a.ph_hi = N_PHASES;
        void* kargs[] = {&a};
        hipError_t e = hipLaunchCooperativeKernel((const void*)hymba_fwd, dim3(grid), dim3(NWAVES * 64), kargs, LDS_BYTES, stream);
        if (e != hipSuccess) fprintf(stderr, "cooperative launch failed: %s (grid %d)\n", hipGetErrorString(e), grid);
    } else {
        for (int p = 0; p < N_PHASES; ++p) { a.ph_lo = p; a.ph_hi = p + 1; hipLaunchKernelGGL(hymba_fwd, dim3(grid), dim3(NWAVES * 64), LDS_BYTES, stream, a); }
    }
}
```

```cpp
#include <hip/hip_runtime.h>
#include <hip/hip_cooperative_groups.h>
#include <cstdio>
#include <cstdint>
namespace cg = cooperative_groups;
__device__ __forceinline__ int hw_lane_id() { int r; asm volatile("v_mbcnt_lo_u32_b32 %0, -1, 0\n\tv_mbcnt_hi_u32_b32 %0, -1, %0" : "=v"(r)); return r; }
__device__ __forceinline__ float lane_xor(float v, int mask) { return __uint_as_float((unsigned)__builtin_amdgcn_ds_bpermute((hw_lane_id() ^ mask) << 2, (int)__float_as_uint(v))); }
namespace pg8 {
#define PG8_LAS __attribute__((address_space(3)))
typedef unsigned short bf16_t;
typedef short bf16x8 __attribute__((ext_vector_type(8)));
typedef float f32x4 __attribute__((ext_vector_type(4)));
typedef unsigned u32x4 __attribute__((ext_vector_type(4)));
constexpr int BM = 256, BK = 64, HALF = 128, HTB = HALF * BK * 2  , STAGE_BYTES = 8 * HTB, NXCD = 8, WGM = 4;

__host__ __device__ __forceinline__ int lds_byte(int r, int c) { const int st = (r >> 4) * 2 + (c >> 5), rr = r & 15, cc = c & 31, ob = rr * 64 + cc * 2; return st * 1024 + (ob ^ (((ob >> 9) & 1) << 5)); }
__host__ __device__ __forceinline__ void stage_rc(int b, int& R, int& C) { const int st = b / 1024, sb = b % 1024, swz = sb ^ (((sb >> 9) & 1) << 5); R = (st >> 1) * 16 + swz / 64; C = (st & 1) * 32 + (swz % 64) / 2; }
__host__ __device__ __forceinline__ int perm32(int rho) { const int n = rho >> 4, i = rho & 15; return 8 * (i >> 2) + 4 * n + (i & 3); }

struct Unit { int pm, pn; };
struct Gemm { const bf16_t* A; const bf16_t* Bt; int M, N, K; };

struct StaticOrder {
    int nM, nN, nwg, G, c, rev, wgm;
    __host__ __device__ void init(int M, int N, int G_, int c_, int rev_ = 0, int wgm_ = WGM) { nM = M / BM; nN = N / BM; nwg = nM * nN; G = G_; c = c_; rev = rev_; wgm = wgm_; }
    __host__ __device__ bool next(int i, Unit& u) const {
        const int nr = (nwg + G - 1) / G; if (i >= nr) return false;
        const long L = (long)(rev ? nr - 1 - i : i) * G + c; if (L >= nwg) return false;
        int wgid = (int)L; { const int q = nwg / NXCD, r = nwg % NXCD, xcd = wgid % NXCD, off = wgid / NXCD; wgid = (xcd < r ? xcd * (q + 1) : r * (q + 1) + (xcd - r) * q) + off; }
        const int nig = wgm * nN, gid = wgid / nig, fm = gid * wgm, gsz = (nM - fm) < wgm ? (nM - fm) : wgm;
        u.pm = fm + ((wgid % nig) % gsz); u.pn = (wgid % nig) / gsz; return true;
    }
    __device__ __forceinline__ void a_ready(const Unit&) const {}
    __device__ __forceinline__ void done(const Unit&) const {}
};
__device__ __forceinline__ unsigned cvt_pk_bf16(float lo, float hi) { unsigned r; asm volatile("v_cvt_pk_bf16_f32 %0, %1, %2" : "=v"(r) : "v"(lo), "v"(hi)); return r; }
typedef float f32x2 __attribute__((ext_vector_type(2)));
#ifndef EPI_NT_Z
#define EPI_NT_Z 0
#endif
#ifndef EPI_NT_H
#define EPI_NT_H 1
#endif
#ifndef EPI_WT
#define EPI_WT 0
#endif
__device__ __forceinline__ void st16(void* base, unsigned off, u32x4 v) {
#if EPI_WT
    __amdgpu_buffer_rsrc_t r = __builtin_amdgcn_make_buffer_rsrc(base, 0, 0x7fffffff, 0x00020000);
    __builtin_amdgcn_raw_buffer_store_b128(v, r, off, 0, 16);
#else
    *(u32x4*)((char*)base + off) = v;
#endif
}
template <int ACT> struct EpiScale {
    static constexpr bool PERM = true, AFTER_DRAIN = false;
    bf16_t* O; int ldc; const unsigned long long* ss; float inv_n, eps;
    __device__ __forceinline__ void operator()(const f32x4 (&acc)[2][2][4][2], const Unit& u, int wr, int wc, int fr_, int fq_) const {
        (void)fr_; (void)fq_; const int ln_ = hw_lane_id(); const int fr = ln_ & 15, fq = ln_ >> 4;
        const int row0 = u.pm * BM + wr * 64 + fr; const int col0 = u.pn * BM + wc * 64 + 8 * fq;
        float rr[2][4];
        if (ACT == 0) { unsigned long long sv[2][4];
#pragma unroll
            for (int ai = 0; ai < 2; ++ai)
#pragma unroll
                for (int m = 0; m < 4; ++m) sv[ai][m] = ss[row0 + ai * HALF + m * 16];
#pragma unroll
            for (int ai = 0; ai < 2; ++ai)
#pragma unroll
                for (int m = 0; m < 4; ++m) rr[ai][m] = __builtin_amdgcn_rsqf((float)sv[ai][m] * inv_n + eps);
            asm volatile("" : "+v"(rr[0][0]), "+v"(rr[0][1]), "+v"(rr[0][2]), "+v"(rr[0][3]), "+v"(rr[1][0]), "+v"(rr[1][1]), "+v"(rr[1][2]), "+v"(rr[1][3])); }
#pragma unroll
        for (int ai = 0; ai < 2; ++ai)
#pragma unroll
            for (int m = 0; m < 4; ++m) { const int row = row0 + ai * HALF + m * 16; float r = 1.f; if (ACT == 0) r = rr[ai][m];
#pragma unroll
                for (int bj = 0; bj < 2; ++bj) { f32x4 v0 = acc[ai][bj][m][0], v1 = acc[ai][bj][m][1];
                    if (ACT == 0) { v0 = v0 * r; v1 = v1 * r; }
                    else {
#pragma unroll
                        for (int e = 0; e < 4; ++e) { v0[e] = __builtin_fmaxf(v0[e], 0.f); v1[e] = __builtin_fmaxf(v1[e], 0.f); }
                        v0 = v0 * v0; v1 = v1 * v1; }
                    u32x4 w; w.x = cvt_pk_bf16(v0[0], v0[1]); w.y = cvt_pk_bf16(v0[2], v0[3]); w.z = cvt_pk_bf16(v1[0], v1[1]); w.w = cvt_pk_bf16(v1[2], v1[3]);
                    if ((ACT == 1 || EPI_NT_Z) && EPI_NT_H) __builtin_nontemporal_store(w, (u32x4*)(O + (size_t)row * ldc + col0 + bj * 32));
                    else st16(O, (unsigned)(((size_t)row * ldc + col0 + bj * 32) * 2), w); } }
    }
};
struct EpiResid {
    static constexpr bool PERM = true, AFTER_DRAIN = false;
    const float* base; float* out; bf16_t* xb; float* ss_out; int ldc;
    __device__ __forceinline__ void operator()(const f32x4 (&acc)[2][2][4][2], const Unit& u, int wr, int wc, int fr_, int fq_) const {
        (void)fr_; (void)fq_; const int ln_ = hw_lane_id(); const int fr = ln_ & 15, fq = ln_ >> 4;
        const int row0 = u.pm * BM + wr * 64 + fr; const int col0 = u.pn * BM + wc * 64 + 8 * fq;
#pragma unroll
        for (int ai = 0; ai < 2; ++ai)
#pragma unroll
            for (int m = 0; m < 4; ++m) { const int row = row0 + ai * HALF + m * 16; const size_t off = (size_t)row * ldc + col0; float s = 0.f;
#pragma unroll
                for (int bj = 0; bj < 2; ++bj) { const f32x4 b0 = *(const f32x4*)(base + off + bj * 32), b1 = *(const f32x4*)(base + off + bj * 32 + 4);
                    const f32x4 v0 = acc[ai][bj][m][0] + b0, v1 = acc[ai][bj][m][1] + b1;
                    *(f32x4*)(out + off + bj * 32) = v0; *(f32x4*)(out + off + bj * 32 + 4) = v1;
                    u32x4 w; w.x = cvt_pk_bf16(v0[0], v0[1]); w.y = cvt_pk_bf16(v0[2], v0[3]); w.z = cvt_pk_bf16(v1[0], v1[1]); w.w = cvt_pk_bf16(v1[2], v1[3]);
                    *(u32x4*)(xb + off + bj * 32) = w;
                    s += (v0[0] * v0[0] + v0[1] * v0[1]) + (v0[2] * v0[2] + v0[3] * v0[3]) + (v1[0] * v1[0] + v1[1] * v1[1]) + (v1[2] * v1[2] + v1[3] * v1[3]); }
                s += lane_xor(s, 16); s += lane_xor(s, 32);
                if (fq == 0) unsafeAtomicAdd(ss_out + row, s); }
    }
};
template <bool SCALE> struct EpiResidBT {
    static constexpr bool PERM = true, AFTER_DRAIN = false;
    bf16_t* xb; unsigned long long* ss_out; int ldc; const unsigned long long* ss_in; float inv_n, eps;
    __device__ __forceinline__ void operator()(const f32x4 (&acc)[2][2][4][2], const Unit& u, int wr, int wc, int fr_, int fq_) const {
        (void)fr_; (void)fq_; const int ln_ = hw_lane_id(); const int fr = ln_ & 15, fq = ln_ >> 4;
        const int row0 = u.pm * BM + wr * 64 + fr; const int col0 = u.pn * BM + wc * 64 + 8 * fq;
        float sacc[2][4];
#pragma unroll
        for (int ai = 0; ai < 2; ++ai) {
            u32x4 rb[4][2]; unsigned long long sv[4];
#pragma unroll
            for (int m = 0; m < 4; ++m) { const int row = row0 + ai * HALF + m * 16; const bf16_t* p = xb + (size_t)row * ldc + col0;
                rb[m][0] = *(const u32x4*)(p); rb[m][1] = *(const u32x4*)(p + 32); if (SCALE) sv[m] = ss_in[row]; }
#pragma unroll
            for (int m = 0; m < 4; ++m) { const int row = row0 + ai * HALF + m * 16; f32x2 s2 = (f32x2){0.f, 0.f};
                float r2 = 1.f; if (SCALE) r2 = __builtin_amdgcn_rcpf((float)sv[m] * inv_n + eps);
#pragma unroll
                for (int bj = 0; bj < 2; ++bj) { const u32x4 b = rb[m][bj];
                    const f32x4 b0 = (f32x4){__uint_as_float(b.x << 16), __uint_as_float(b.x & 0xffff0000u), __uint_as_float(b.y << 16), __uint_as_float(b.y & 0xffff0000u)};
                    const f32x4 b1 = (f32x4){__uint_as_float(b.z << 16), __uint_as_float(b.z & 0xffff0000u), __uint_as_float(b.w << 16), __uint_as_float(b.w & 0xffff0000u)};
                    f32x4 v0, v1;
                    if (SCALE) { v0 = acc[ai][bj][m][0] * r2 + b0; v1 = acc[ai][bj][m][1] * r2 + b1; } else { v0 = acc[ai][bj][m][0] + b0; v1 = acc[ai][bj][m][1] + b1; }
                    u32x4 w; w.x = cvt_pk_bf16(v0[0], v0[1]); w.y = cvt_pk_bf16(v0[2], v0[3]); w.z = cvt_pk_bf16(v1[0], v1[1]); w.w = cvt_pk_bf16(v1[2], v1[3]);
                    st16(xb, (unsigned)(((size_t)row * ldc + col0 + bj * 32) * 2), w);
                    s2 = __builtin_elementwise_fma((f32x2){v0[0], v0[1]}, (f32x2){v0[0], v0[1]}, s2); s2 = __builtin_elementwise_fma((f32x2){v0[2], v0[3]}, (f32x2){v0[2], v0[3]}, s2);
                    s2 = __builtin_elementwise_fma((f32x2){v1[0], v1[1]}, (f32x2){v1[0], v1[1]}, s2); s2 = __builtin_elementwise_fma((f32x2){v1[2], v1[3]}, (f32x2){v1[2], v1[3]}, s2); }
                float s = s2.x + s2.y;
                s += lane_xor(s, 16); s += lane_xor(s, 32);
                sacc[ai][m] = s; }
        }
        if (fq == 0) {
#pragma unroll
            for (int ai = 0; ai < 2; ++ai)
#pragma unroll
                for (int m = 0; m < 4; ++m) atomicAdd(ss_out + row0 + ai * HALF + m * 16, (unsigned long long)(sacc[ai][m] * 16777216.0f + 0.5f)); }
    }
};
template <class Epi, class Sched, bool ALIGN_EPI = false, bool SP2 = false, bool A_NT = false>
__device__ __forceinline__ void gemm_phase(PG8_LAS unsigned char* lds, const Gemm g, const Sched& S, const Epi& E, const int wave_id) {
    int tid_ = wave_id * 64 + hw_lane_id(); asm volatile("" : "+v"(tid_));
    const int tid = tid_, wid = __builtin_amdgcn_readfirstlane(tid >> 6), lane = tid & 63, wr = wid >> 2, wc = wid & 3, fr = lane & 15, fq = lane >> 4;
    const int K = g.K, nt = K / BK;
    constexpr int aux_voffA = A_NT ? 2 : 0, aux_voffB = 0;
    unsigned voffA[2], voffB[2];
#pragma unroll
    for (int i = 0; i < 2; ++i) { int R, C; stage_rc(tid * 16 + i * 8192, R, C); const int Rb = Epi::PERM ? (64 * (R >> 5) + perm32(R & 31)) : R;
        voffA[i] = (unsigned)(R * K + C) * 2u; voffB[i] = (unsigned)(Rb * K + C) * 2u; }
    const size_t kstep = (size_t)(BK * 2);
    const size_t hstep = (size_t)HALF * K * 2;
    const size_t hstepB = Epi::PERM ? (size_t)32 * K * 2 : hstep;
    const size_t tstep = 2 * hstep;
    const unsigned ldsw = (unsigned)wid * 1024u;
    const int aoff = lds_byte(wr * 64 + fr, fq * 8), boff = lds_byte(wc * 32 + fr, fq * 8);
#define PG8_SA(b, h) (((b) * 2 + (h)) * HTB)
#define PG8_SB(b, h) ((4 + (b) * 2 + (h)) * HTB)
#define PG8_STAGE(bufoff, gbase, voff) do { _Pragma("unroll") for (int _i = 0; _i < 2; ++_i) \
        __builtin_amdgcn_global_load_lds((const unsigned*)((const char*)(gbase) + (voff)[_i]), (PG8_LAS unsigned*)(lds + (bufoff) + ldsw + _i * 8192), 16, 0, aux_##voff); } while (0)
#define PG8_LDA(dst, b, h) do { _Pragma("unroll") for (int m = 0; m < 4; ++m) _Pragma("unroll") for (int k = 0; k < 2; ++k) dst[m][k] = *(const PG8_LAS bf16x8*)(lds + PG8_SA(b, h) + aoff + m * 2048 + k * 1024); } while (0)
#define PG8_LDB(dst, b, h) do { _Pragma("unroll") for (int n = 0; n < 2; ++n) _Pragma("unroll") for (int k = 0; k < 2; ++k) dst[n][k] = *(const PG8_LAS bf16x8*)(lds + PG8_SB(b, h) + boff + n * 2048 + k * 1024); } while (0)
#define PG8_MMA(ai, bj, At, Bt) do { __builtin_amdgcn_s_setprio(1); _Pragma("unroll") for (int m = 0; m < 4; ++m) _Pragma("unroll") for (int n = 0; n < 2; ++n) _Pragma("unroll") for (int k = 0; k < 2; ++k) \
        acc[ai][bj][m][n] = __builtin_amdgcn_mfma_f32_16x16x32_bf16(Bt[n][k], At[m][k], acc[ai][bj][m][n], 0, 0, 0); __builtin_amdgcn_s_setprio(0); } while (0)
#define PG8_WAIT_V(n) asm volatile("s_waitcnt vmcnt(" #n ")" ::: "memory")
#define PG8_WAIT_L(n) asm volatile("s_waitcnt lgkmcnt(" #n ")" ::: "memory")
#define PG8_BAR __builtin_amdgcn_s_barrier()
#define PG8_SCHED __builtin_amdgcn_sched_barrier(0)
    Unit cur, nxt; int ui = 0;
    if (!S.next(0, cur)) return;
    f32x4 acc[2][2][4][2];
#pragma unroll
    for (int a = 0; a < 2; ++a)
#pragma unroll
        for (int b = 0; b < 2; ++b)
#pragma unroll
            for (int m = 0; m < 4; ++m)
#pragma unroll
                for (int n = 0; n < 2; ++n) acc[a][b][m][n] = (f32x4){0.f, 0.f, 0.f, 0.f};
    bf16x8 At[4][2], B0[2][2], B1[2][2];
    const char* cA = (const char*)g.A + (size_t)cur.pm * tstep; const char* cB = (const char*)g.Bt + (size_t)cur.pn * tstep;
    S.a_ready(cur);
    if constexpr (SP2) {
        PG8_STAGE(PG8_SB(0, 0), cB, voffB); PG8_STAGE(PG8_SB(0, 1), cB + hstepB, voffB); PG8_STAGE(PG8_SA(0, 0), cA, voffA); PG8_STAGE(PG8_SA(0, 1), cA + hstep, voffA);
        if (wr == 1) PG8_BAR;
        PG8_WAIT_V(2); PG8_BAR;
        PG8_STAGE(PG8_SB(1, 0), cB + kstep, voffB); PG8_STAGE(PG8_SA(1, 0), cA + kstep, voffA); PG8_STAGE(PG8_SB(1, 1), cB + hstepB + kstep, voffB);
        PG8_WAIT_V(6); PG8_BAR;
    } else {
        PG8_STAGE(PG8_SB(0, 0), cB, voffB); PG8_STAGE(PG8_SA(0, 0), cA, voffA); PG8_STAGE(PG8_SB(0, 1), cB + hstepB, voffB); PG8_STAGE(PG8_SA(0, 1), cA + hstep, voffA);
        if (wr == 1) PG8_BAR;
        PG8_WAIT_V(4); PG8_BAR;
        PG8_STAGE(PG8_SB(1, 0), cB + kstep, voffB); PG8_STAGE(PG8_SA(1, 0), cA + kstep, voffA); PG8_STAGE(PG8_SB(1, 1), cB + hstepB + kstep, voffB);
        PG8_WAIT_V(6); PG8_BAR;
    }
    for (;;) {
        const bool has_next = S.next(ui + 1, nxt);
        const char* nA = has_next ? (const char*)g.A + (size_t)nxt.pm * tstep : cA; const char* nB = has_next ? (const char*)g.Bt + (size_t)nxt.pn * tstep : cB;
        for (int t = 0; t < nt; t += 2) {
            const bool last = (t == nt - 2);
            const char* a1 = cA + (size_t)(t + 1) * kstep;
            const char* a2 = last ? nA : cA + (size_t)(t + 2) * kstep; const char* b2 = last ? nB : cB + (size_t)(t + 2) * kstep;
            const char* a3 = a2 + kstep; const char* b3 = b2 + kstep;
            if (last && has_next) S.a_ready(nxt);
            if constexpr (SP2) {
            PG8_LDB(B0, 0, 0); PG8_LDB(B1, 0, 1); PG8_SCHED; PG8_LDA(At, 0, 0); PG8_STAGE(PG8_SA(1, 1), a1 + hstep, voffA);
            PG8_WAIT_V(8); PG8_WAIT_L(0); PG8_BAR; PG8_MMA(0, 0, At, B0); PG8_MMA(0, 1, At, B1); PG8_BAR; PG8_SCHED;
            PG8_LDA(At, 0, 1); PG8_STAGE(PG8_SB(0, 0), b2, voffB); PG8_STAGE(PG8_SB(0, 1), b2 + hstepB, voffB); PG8_STAGE(PG8_SA(0, 0), a2, voffA);
            PG8_WAIT_V(8); PG8_WAIT_L(0); PG8_BAR; PG8_MMA(1, 0, At, B0); PG8_MMA(1, 1, At, B1); PG8_BAR; PG8_SCHED;
            PG8_LDB(B0, 1, 0); PG8_LDB(B1, 1, 1); PG8_SCHED; PG8_LDA(At, 1, 0); PG8_STAGE(PG8_SA(0, 1), a2 + hstep, voffA);
            PG8_WAIT_V(8); PG8_WAIT_L(0); PG8_BAR; PG8_MMA(0, 0, At, B0); PG8_MMA(0, 1, At, B1); PG8_BAR; PG8_SCHED;
            PG8_LDA(At, 1, 1); PG8_STAGE(PG8_SB(1, 0), b3, voffB); PG8_STAGE(PG8_SB(1, 1), b3 + hstepB, voffB); PG8_STAGE(PG8_SA(1, 0), a3, voffA);
            PG8_WAIT_V(8); PG8_WAIT_L(0); PG8_BAR; PG8_MMA(1, 0, At, B0); PG8_MMA(1, 1, At, B1); PG8_BAR; PG8_SCHED;
            } else {
            PG8_LDB(B0, 0, 0); PG8_SCHED; PG8_LDA(At, 0, 0); PG8_STAGE(PG8_SA(1, 1), a1 + hstep, voffA);
            PG8_WAIT_L(8); PG8_BAR; PG8_WAIT_L(0); PG8_MMA(0, 0, At, B0); PG8_BAR; PG8_SCHED;
            PG8_LDB(B1, 0, 1); PG8_STAGE(PG8_SB(0, 0), b2, voffB);
            PG8_BAR; PG8_WAIT_L(0); PG8_MMA(0, 1, At, B1); PG8_BAR;
            PG8_LDA(At, 0, 1); PG8_STAGE(PG8_SA(0, 0), a2, voffA);
            PG8_BAR; PG8_WAIT_L(0); PG8_MMA(1, 0, At, B0); PG8_BAR; PG8_SCHED;
            PG8_STAGE(PG8_SB(0, 1), b2 + hstepB, voffB);
            PG8_WAIT_V(6); PG8_BAR; PG8_MMA(1, 1, At, B1); PG8_BAR;
            PG8_LDB(B0, 1, 0); PG8_SCHED; PG8_LDA(At, 1, 0); PG8_STAGE(PG8_SA(0, 1), a2 + hstep, voffA);
            PG8_WAIT_L(8); PG8_BAR; PG8_WAIT_L(0); PG8_MMA(0, 0, At, B0); PG8_BAR; PG8_SCHED;
            PG8_LDB(B1, 1, 1); PG8_STAGE(PG8_SB(1, 0), b3, voffB);
            PG8_BAR; PG8_WAIT_L(0); PG8_MMA(0, 1, At, B1); PG8_BAR;
            PG8_LDA(At, 1, 1); PG8_STAGE(PG8_SA(1, 0), a3, voffA);
            PG8_BAR; PG8_WAIT_L(0); PG8_MMA(1, 0, At, B0); PG8_BAR; PG8_SCHED;
            PG8_STAGE(PG8_SB(1, 1), b3 + hstepB, voffB);
            PG8_WAIT_V(6); PG8_BAR; PG8_MMA(1, 1, At, B1); PG8_BAR;
            }
        }
        if constexpr (ALIGN_EPI) { if (wr == 0) PG8_BAR; }
        if constexpr (!Epi::AFTER_DRAIN) { E(acc, cur, wr, wc, fr, fq); S.done(cur); }
        if (!has_next) break;
#pragma unroll
        for (int a = 0; a < 2; ++a)
#pragma unroll
            for (int b = 0; b < 2; ++b)
#pragma unroll
                for (int m = 0; m < 4; ++m)
#pragma unroll
                    for (int n = 0; n < 2; ++n) acc[a][b][m][n] = (f32x4){0.f, 0.f, 0.f, 0.f};
        cur = nxt; cA = nA; cB = nB; ++ui;
        if constexpr (ALIGN_EPI) { if (wr == 1) PG8_BAR; }
    }
    PG8_WAIT_V(0);
    if constexpr (!ALIGN_EPI) { if (wr == 0) PG8_BAR; }
    PG8_BAR;
    if constexpr (Epi::AFTER_DRAIN) { E.fused(acc, cur, wr, wc, fr, fq, lds, wid, lane); S.done(cur); }
#undef PG8_SA
#undef PG8_SB
#undef PG8_STAGE
#undef PG8_LDA
#undef PG8_LDB
#undef PG8_MMA
#undef PG8_WAIT_V
#undef PG8_WAIT_L
#undef PG8_BAR
#undef PG8_SCHED
}
}
namespace att {
typedef unsigned short bf16_t;
typedef short bf16x8 __attribute__((ext_vector_type(8)));
typedef short s16x4 __attribute__((ext_vector_type(4)));
typedef float f32x16 __attribute__((ext_vector_type(16)));
typedef unsigned u32x4 __attribute__((ext_vector_type(4)));
#define ALAS __attribute__((address_space(3)))
constexpr int ZP = 2560;
constexpr int KCS = 6160;
constexpr int VDH = 24576;
constexpr int LDS_K = 0, LDS_V = 8 * KCS  , LDS_WS = LDS_V + 2 * VDH  , LDS_OST = LDS_WS + 8 * 256  , LDS_END = LDS_OST + 8 * 4096;
__device__ __forceinline__ int crow(int r, int hi) { return (r & 3) + 8 * (r >> 2) + 4 * hi; }
__device__ __forceinline__ unsigned cvtpk(float lo, float hi) { unsigned r; asm volatile("v_cvt_pk_bf16_f32 %0, %1, %2" : "=v"(r) : "v"(lo), "v"(hi)); return r; }
__device__ __forceinline__ float swapmax(float m) { auto rr = __builtin_amdgcn_permlane32_swap(__float_as_uint(m), __float_as_uint(m), false, false); return __builtin_fmaxf(__uint_as_float(rr[0]), __uint_as_float(rr[1])); }
__device__ __forceinline__ float swapsum(float m) { auto rr = __builtin_amdgcn_permlane32_swap(__float_as_uint(m), __float_as_uint(m), false, false); return __uint_as_float(rr[0]) + __uint_as_float(rr[1]); }
template <int OFF> __device__ __forceinline__ void pv32(f32x16* o, int vb, bf16x8 pa0, bf16x8 pa1) {
#pragma unroll
    for (int d0 = 0; d0 < 2; ++d0) { s16x4 lo[2], hi[2];
#pragma unroll
        for (int ks = 0; ks < 2; ++ks) {
            asm volatile("ds_read_b64_tr_b16 %0,%1 offset:%c2" : "=&v"(lo[ks]) : "v"(vb), "i"(d0 * VDH + OFF + ks * 1024) : "memory");
            asm volatile("ds_read_b64_tr_b16 %0,%1 offset:%c2" : "=&v"(hi[ks]) : "v"(vb), "i"(d0 * VDH + OFF + ks * 1024 + 512) : "memory"); }
        asm volatile("s_waitcnt lgkmcnt(0)" ::: "memory"); __builtin_amdgcn_sched_barrier(0);
#define PK(k) (bf16x8){lo[k][0], lo[k][1], lo[k][2], lo[k][3], hi[k][0], hi[k][1], hi[k][2], hi[k][3]}
        o[d0] = __builtin_amdgcn_mfma_f32_32x32x16_bf16(pa0, PK(0), o[d0], 0, 0, 0);
        o[d0] = __builtin_amdgcn_mfma_f32_32x32x16_bf16(pa1, PK(1), o[d0], 0, 0, 0);
#undef PK
    }
}
struct UnitP { int kind, h, dil, q0, qb, qcol, kcol, vcol; long rowb; };
__device__ __forceinline__ UnitP decode(int u) {
    UnitP p; int b, idx16;
    if (u < 2304) { idx16 = u & 15; p.h = (u >> 4) % 6; const int kb = u / 96; p.kind = kb % 3; b = kb / 3; }
    else { const int u3 = u - 2304, g = u3 >> 8, rest = u3 & 255; idx16 = rest & 15; const int kvh = (rest >> 4) & 1; b = rest >> 5; p.h = 3 * kvh + g; p.kind = 3; }
    const int lg = (p.kind == 1) ? 2 : (p.kind == 2) ? 4 : 0; p.dil = 1 << lg;
    const int res = idx16 & (p.dil - 1); p.qb = idx16 >> lg; p.q0 = p.qb * 256;
    p.qcol = (p.kind < 3 ? 0 : 1920) + p.h * 64; p.kcol = (p.kind < 3) ? 384 + p.h * 64 : 2304 + (p.h / 3) * 64; p.vcol = (p.kind < 3) ? 768 + p.h * 64 : 2432 + (p.h / 3) * 64;
    p.rowb = (long)b * 4096 + res; return p;
}
__device__ __forceinline__ UnitP decode_local(int j, int b) {
    UnitP p; int idx16;
    if (j < 288) { idx16 = j & 15; p.h = (j >> 4) % 6; p.kind = j / 96; }
    else { const int j3 = j - 288, g = j3 >> 5, rest = j3 & 31; idx16 = rest & 15; const int kvh = rest >> 4; p.h = 3 * kvh + g; p.kind = 3; }
    const int lg = (p.kind == 1) ? 2 : (p.kind == 2) ? 4 : 0; p.dil = 1 << lg;
    const int res = idx16 & (p.dil - 1); p.qb = idx16 >> lg; p.q0 = p.qb * 256;
    p.qcol = (p.kind < 3 ? 0 : 1920) + p.h * 64; p.kcol = (p.kind < 3) ? 384 + p.h * 64 : 2304 + (p.h / 3) * 64; p.vcol = (p.kind < 3) ? 768 + p.h * 64 : 2432 + (p.h / 3) * 64;
    p.rowb = (long)b * 4096 + res; return p;
}
__device__ __forceinline__ void issue_loads(const UnitP& p, const bf16_t* __restrict__ Z, int tid, int wid, int r32, int hi, u32x4 (&kr)[6], u32x4 (&vr)[6], bf16x8 (&qn)[4]) {
    const __amdgpu_buffer_rsrc_t rz = __builtin_amdgcn_make_buffer_rsrc((void*)Z, 0, 32768 * ZP * 2, 0x00020000);
    const int kk0 = tid >> 3, c8 = tid & 7;
    const int rowb = (int)p.rowb;
#pragma unroll
    for (int j = 0; j < 6; ++j) { int sj = p.q0 - 128 + 64 * j; asm volatile("" : "+s"(sj));
        const int kpos = kk0 + sj;
        const unsigned rofs = (unsigned)((rowb + p.dil * kpos) * ZP + c8 * 8) * 2u;
        const unsigned ko = kpos >= 0 ? rofs + (unsigned)p.kcol * 2u : 0xFFFFFFFFu, vo = kpos >= 0 ? rofs + (unsigned)p.vcol * 2u : 0xFFFFFFFFu;
        kr[j] = __builtin_amdgcn_raw_buffer_load_b128(rz, ko, 0, 0); vr[j] = __builtin_amdgcn_raw_buffer_load_b128(rz, vo, 0, 0); }
    const int ql = tid & 63;
#pragma unroll
    for (int i = 0; i < 4; ++i) { const int rq = rowb + p.dil * (p.q0 + 32 * wid + 8 * i + (ql >> 3)); qn[i] = __builtin_bit_cast(bf16x8, (u32x4)__builtin_amdgcn_raw_buffer_load_b128(rz, (unsigned)(rq * ZP + p.qcol + (ql & 7) * 8) * 2u, 0, 0)); }
    (void)r32; (void)hi;
}
__device__ __forceinline__ void attn_phase(const bf16_t* __restrict__ Z, bf16_t* __restrict__ OA, bf16_t* __restrict__ OC, float* __restrict__ LSEb, const float* __restrict__ sinks_l, char* shm, int G, int T_ROWS, const int wave_id) {
    int tid_ = wave_id * 64 + hw_lane_id(); asm volatile("" : "+v"(tid_));
    const int tid = tid_, lane = tid & 63, r32 = lane & 31, hi = lane >> 5; const int wid = __builtin_amdgcn_readfirstlane(tid >> 6);
    ALAS char* sh = (ALAS char*)shm;
    const bool aff = (G == 256); const int bx = (int)(blockIdx.x & 7), ustep = aff ? 32 : G, uend = aff ? 384 : 3072;
    int u = aff ? (int)(blockIdx.x >> 3) : ((G % 8 == 0) ? (int)(blockIdx.x % 8) * (G / 8) + (int)(blockIdx.x / 8) : (int)blockIdx.x); if (u >= uend) return;
#define DECODE(U) (aff ? decode_local((U), bx) : decode(U))
    float sk[6];
#pragma unroll
    for (int i = 0; i < 6; ++i) sk[i] = __uint_as_float(__builtin_amdgcn_readfirstlane(__float_as_uint(sinks_l[i] * 1.4426950408889634f)));
    u32x4 kr[6], vr[6]; bf16x8 qn[4];
    { const UnitP p0 = DECODE(u); issue_loads(p0, Z, tid, wid, r32, hi, kr, vr, qn); }
    for (;;) {
        const UnitP up = DECODE(u);
        bf16_t* __restrict__ O = (up.kind < 3) ? OA + (size_t)up.kind * T_ROWS * 384 : OC;
        float* __restrict__ LSE = LSEb + (size_t)up.kind * T_ROWS * 6;
        const float sink2 = (up.kind == 3) ? sk[up.h] : 0.f;
        const int kind = up.kind, h = up.h, dil = up.dil, q0 = up.q0, qb = up.qb; const long rowb = up.rowb;
        const long rowq = rowb + (long)dil * (q0 + 32 * wid + r32);
        bf16x8 qr[4];
#pragma unroll
        for (int i = 0; i < 4; ++i) { const int row = 8 * i + (lane >> 3); *(ALAS bf16x8*)(sh + LDS_OST + wid * 4096 + row * 128 + (((lane & 7) ^ (row & 7)) * 16)) = qn[i]; }
        asm volatile("s_waitcnt lgkmcnt(0)" ::: "memory");
#pragma unroll
        for (int d0 = 0; d0 < 4; ++d0) qr[d0] = *(ALAS const bf16x8*)(sh + LDS_OST + wid * 4096 + r32 * 128 + (((2 * d0 + hi) ^ (r32 & 7)) * 16));
#pragma unroll
        for (int j = 0; j < 6; ++j) { const int i = tid + 512 * j, kk = i >> 3, c8 = i & 7;
            *(ALAS u32x4*)(sh + LDS_K + c8 * KCS + kk * 16) = kr[j];
            *(ALAS u32x4*)(sh + LDS_V + (c8 >> 2) * VDH + (kk >> 4) * 1024 + (kk & 15) * 64 + (c8 & 3) * 16) = vr[j]; }
        __syncthreads();
        const int un = u + ustep;
        if (un < uend) { const UnitP pn = DECODE(un); issue_loads(pn, Z, tid, wid, r32, hi, kr, vr, qn); }
        asm volatile("" ::: "memory");
        f32x16 p[5];
        { const int kaddr = (int)(unsigned)(uintptr_t)(shm + LDS_K) + hi * KCS + (32 * wid + r32) * 16;
#define KRD(dst, OFF) asm volatile("ds_read_b128 %0, %1 offset:%c2" : "=&v"(dst) : "v"(kaddr), "i"(OFF) : "memory")
#define KRD4(F, BLK) do { KRD(F[0], 0 * 2 * KCS + (BLK) * 512); KRD(F[1], 1 * 2 * KCS + (BLK) * 512); KRD(F[2], 2 * 2 * KCS + (BLK) * 512); KRD(F[3], 3 * 2 * KCS + (BLK) * 512); } while (0)
#define QK2(PA, FA, PB, FB) do { f32x16 z_ = {}; \
            PA = __builtin_amdgcn_mfma_f32_32x32x16_bf16(FA[0], qr[0], z_, 0, 0, 0); PB = __builtin_amdgcn_mfma_f32_32x32x16_bf16(FB[0], qr[0], z_, 0, 0, 0); \
            PA = __builtin_amdgcn_mfma_f32_32x32x16_bf16(FA[1], qr[1], PA, 0, 0, 0); PB = __builtin_amdgcn_mfma_f32_32x32x16_bf16(FB[1], qr[1], PB, 0, 0, 0); \
            PA = __builtin_amdgcn_mfma_f32_32x32x16_bf16(FA[2], qr[2], PA, 0, 0, 0); PB = __builtin_amdgcn_mfma_f32_32x32x16_bf16(FB[2], qr[2], PB, 0, 0, 0); \
            PA = __builtin_amdgcn_mfma_f32_32x32x16_bf16(FA[3], qr[3], PA, 0, 0, 0); PB = __builtin_amdgcn_mfma_f32_32x32x16_bf16(FB[3], qr[3], PB, 0, 0, 0); } while (0)
          bf16x8 f0[4], f1[4];
          KRD4(f0, 0); KRD4(f1, 1);
          asm volatile("s_waitcnt lgkmcnt(0)" ::: "memory"); __builtin_amdgcn_sched_barrier(0);
          QK2(p[0], f0, p[1], f1);
          __builtin_amdgcn_sched_barrier(0);
          KRD4(f0, 2); KRD4(f1, 3);
          asm volatile("s_waitcnt lgkmcnt(0)" ::: "memory"); __builtin_amdgcn_sched_barrier(0);
          QK2(p[2], f0, p[3], f1);
          __builtin_amdgcn_sched_barrier(0);
          KRD4(f0, 4);
          asm volatile("s_waitcnt lgkmcnt(0)" ::: "memory"); __builtin_amdgcn_sched_barrier(0);
          { f32x16 z_ = {}; p[4] = __builtin_amdgcn_mfma_f32_32x32x16_bf16(f0[0], qr[0], z_, 0, 0, 0);
            p[4] = __builtin_amdgcn_mfma_f32_32x32x16_bf16(f0[1], qr[1], p[4], 0, 0, 0); p[4] = __builtin_amdgcn_mfma_f32_32x32x16_bf16(f0[2], qr[2], p[4], 0, 0, 0); p[4] = __builtin_amdgcn_mfma_f32_32x32x16_bf16(f0[3], qr[3], p[4], 0, 0, 0); }
#undef KRD
#undef KRD4
#undef QK2
        }
        const float NEG = -INFINITY; const int lo_thr = r32 + (kind == 3 ? 1 : 0);
#pragma unroll
        for (int r = 0; r < 16; ++r) { const int cr = crow(r, hi); if (cr < lo_thr) p[0][r] = NEG; if (cr > r32) p[4][r] = NEG; }
        const int nskip = (qb == 0) ? 4 - wid : 0;
        float m = p[4][0];
#pragma unroll
        for (int blk = 0; blk < 5; ++blk) if (blk >= nskip) {
#pragma unroll
            for (int r = 0; r < 16; ++r) m = __builtin_fmaxf(m, p[blk][r]); }
        m = swapmax(m);
        if (kind == 3) m = __builtin_fmaxf(m, sink2);
        float l = 0.f;
        { typedef float f2 __attribute__((ext_vector_type(2))); const f2 mm = (f2){m, m}; f2 ls = (f2){0.f, 0.f};
#pragma unroll
          for (int blk = 0; blk < 5; ++blk) {
            if (blk >= nskip) {
#pragma unroll
              for (int r = 0; r < 16; r += 2) { const f2 d = (f2){p[blk][r], p[blk][r + 1]} - mm; f2 e; e.x = __builtin_amdgcn_exp2f(d.x); e.y = __builtin_amdgcn_exp2f(d.y); p[blk][r] = e.x; p[blk][r + 1] = e.y; ls += e; }
            } else {
#pragma unroll
              for (int r = 0; r < 16; ++r) p[blk][r] = 0.f; } }
          l = ls.x + ls.y; }
        l = swapsum(l);
        if (kind == 3) l += __builtin_amdgcn_exp2f(sink2 - m);
        f32x16 o[2]; o[0] = f32x16{}; o[1] = f32x16{};
        const int vb = (int)(unsigned)(uintptr_t)(shm + LDS_V) + (2 * wid) * 1024 + ((lane >> 4) & 1) * 32 + (lane & 3) * 8 + (4 * hi + ((lane & 15) >> 2)) * 64;
#define PA(P, B) __builtin_bit_cast(bf16x8, (u32x4){cvtpk(P[B], P[B + 1]), cvtpk(P[B + 2], P[B + 3]), cvtpk(P[B + 4], P[B + 5]), cvtpk(P[B + 6], P[B + 7])})
#define VRD(dst, OFF) asm volatile("ds_read_b64_tr_b16 %0,%1 offset:%c2" : "=&v"(dst) : "v"(vb), "i"(OFF) : "memory")
#define VRD8(L, H, BLK) do { VRD(L[0], 0 * VDH + (BLK) * 2048); VRD(H[0], 0 * VDH + (BLK) * 2048 + 512); VRD(L[1], 0 * VDH + (BLK) * 2048 + 1024); VRD(H[1], 0 * VDH + (BLK) * 2048 + 1536); \
                             VRD(L[2], 1 * VDH + (BLK) * 2048); VRD(H[2], 1 * VDH + (BLK) * 2048 + 512); VRD(L[3], 1 * VDH + (BLK) * 2048 + 1024); VRD(H[3], 1 * VDH + (BLK) * 2048 + 1536); } while (0)
#define VF(L, H, k) (bf16x8){L[k][0], L[k][1], L[k][2], L[k][3], H[k][0], H[k][1], H[k][2], H[k][3]}
#define PV4(P, L, H) do { const bf16x8 a0_ = PA(P, 0), a1_ = PA(P, 8); \
            o[0] = __builtin_amdgcn_mfma_f32_32x32x16_bf16(a0_, VF(L, H, 0), o[0], 0, 0, 0); o[1] = __builtin_amdgcn_mfma_f32_32x32x16_bf16(a0_, VF(L, H, 2), o[1], 0, 0, 0); \
            o[0] = __builtin_amdgcn_mfma_f32_32x32x16_bf16(a1_, VF(L, H, 1), o[0], 0, 0, 0); o[1] = __builtin_amdgcn_mfma_f32_32x32x16_bf16(a1_, VF(L, H, 3), o[1], 0, 0, 0); } while (0)
        { s16x4 la[4], ha[4];
#define PVB(BLK) do { VRD8(la, ha, BLK); asm volatile("s_waitcnt lgkmcnt(0)" ::: "memory"); __builtin_amdgcn_sched_barrier(0); PV4(p[BLK], la, ha); __builtin_amdgcn_sched_barrier(0); } while (0)
          PVB(0); PVB(1); PVB(2); PVB(3); PVB(4);
#undef PVB
        }
#undef PA
#undef VRD
#undef VRD8
#undef VF
#undef PV4
        ALAS float* wsf = (ALAS float*)(sh + LDS_WS) + wid * 64;
        if (hi == 0) wsf[32 + r32] = l;
        LSE[rowq * 6 + h] = m + __builtin_amdgcn_logf(l);
        asm volatile("s_waitcnt lgkmcnt(0)" ::: "memory");
        float rli[16];
#pragma unroll
        for (int r = 0; r < 16; ++r) rli[r] = __builtin_amdgcn_rcpf(wsf[32 + crow(r, hi)]);
        { ALAS bf16_t* stg = (ALAS bf16_t*)(sh + LDS_OST) + wid * 2048;
#pragma unroll
          for (int r = 0; r < 16; ++r) { const int orow = crow(r, hi);
#pragma unroll
            for (int d0 = 0; d0 < 2; ++d0) stg[orow * 64 + d0 * 32 + r32] = (bf16_t)(cvtpk(o[d0][r] * rli[r], 0.f) & 0xffffu); }
          asm volatile("s_waitcnt lgkmcnt(0)" ::: "memory");
#pragma unroll
          for (int i = 0; i < 4; ++i) { const int row = i * 8 + (lane >> 3), ch = lane & 7; const u32x4 v = *(ALAS const u32x4*)(stg + row * 64 + ch * 8);
              const long trow = rowb + (long)dil * (q0 + 32 * wid + row); __builtin_nontemporal_store(v, (u32x4*)(O + trow * 384 + h * 64 + ch * 8));     } }
        __syncthreads();
        if (un >= uend) break;
        u = un;
    }
#undef DECODE
}
#undef ALAS
}
constexpr int NWAVES = 8;
constexpr int T_ROWS = 8 * 4096, DM = 1024, INW = 2560, FF = 4096, DEPTH = 2;
constexpr float EPS = 1e-6f;
constexpr float C2 = 0.125f * 1.4426950408889634f;
constexpr size_t MiB = 1u << 20;
constexpr size_t WS_SS = 436 * MiB;
constexpr size_t WS_W = 1 * MiB;
constexpr size_t W_LAYER = 23 * MiB, W_IN = 0, W_O = 5 * MiB, W_1 = 7 * MiB, W_2 = 15 * MiB;
constexpr size_t WS_XB = 48 * MiB;
constexpr size_t WS_Y = 112 * MiB;
constexpr size_t WS_LSE = 176 * MiB;
constexpr size_t WS_Z = 180 * MiB;
constexpr size_t WS_OA = 340 * MiB;
constexpr size_t WS_OC = 412 * MiB;
constexpr size_t WS_H = 180 * MiB;
constexpr size_t WS_CTL = 438 * MiB, CTL_BYTES = 16384;
constexpr size_t WS_END = 439 * MiB;
constexpr int LDS_BARW = 147392;
constexpr int LDS_BYTES = 147456;

#define GAS __attribute__((address_space(1)))
#define LAS __attribute__((address_space(3)))
typedef unsigned short bf16;
typedef unsigned v4u __attribute__((ext_vector_type(4)));
typedef unsigned v2u __attribute__((ext_vector_type(2)));
typedef float f32x4 __attribute__((ext_vector_type(4)));
__device__ __forceinline__ unsigned pk2(float lo, float hi) { unsigned r; asm volatile("v_cvt_pk_bf16_f32 %0, %1, %2" : "=v"(r) : "v"(lo), "v"(hi)); return r; }
__device__ __forceinline__ float bflo(unsigned u) { return __uint_as_float(u << 16); }
__device__ __forceinline__ float bfhi(unsigned u) { return __uint_as_float(u & 0xffff0000u); }
__device__ __forceinline__ float wave_sum(float v) {
#pragma unroll
    for (int o = 1; o < 64; o <<= 1) v += lane_xor(v, o);
    return v;
}
__device__ __forceinline__ void transpose_item(const float* W, int K, int N, bf16* WT, LAS float* scr, int item, int lane, const float* gk, bool qmode) {
    const int nblk = N / 32, kb = item / nblk, nb = item % nblk, k0 = 64 * kb, n0 = 32 * nb;
    const float cs = (qmode && (n0 < 384 || (n0 >= 1920 && n0 < 2304))) ? C2 : 1.0f;
    const int kr = lane >> 3, c4 = lane & 7;
    f32x4 v[8]; float g[8];
#pragma unroll
    for (int i = 0; i < 8; ++i) { const int kk = 8 * i + kr; v[i] = __builtin_nontemporal_load((const f32x4*)(W + (size_t)(k0 + kk) * N + n0 + 4 * c4)); }
    asm volatile("" ::: "memory");
#pragma unroll
    for (int i = 0; i < 8; ++i) g[i] = (gk ? gk : W)[k0 + 8 * i + kr];
#pragma unroll
    for (int i = 0; i < 8; ++i) g[i] = gk ? g[i] * cs : cs;
#pragma unroll
    for (int i = 0; i < 8; ++i) { const int kk = 8 * i + kr; LAS float* d = scr + kk * 33 + 4 * c4; d[0] = v[i].x * g[i]; d[1] = v[i].y * g[i]; d[2] = v[i].z * g[i]; d[3] = v[i].w * g[i]; }
    asm volatile("s_waitcnt lgkmcnt(0)" ::: "memory");
    const int c = lane & 7;
#pragma unroll
    for (int j = 0; j < 4; ++j) { const int n = (lane >> 3) + 8 * j; const LAS float* s = scr + (8 * c) * 33 + n;
        v4u o; o.x = pk2(s[0 * 33], s[1 * 33]); o.y = pk2(s[2 * 33], s[3 * 33]); o.z = pk2(s[4 * 33], s[5 * 33]); o.w = pk2(s[6 * 33], s[7 * 33]);
        *(v4u*)(WT + (size_t)(n0 + n) * K + k0 + 8 * c) = o; }
    asm volatile("s_waitcnt lgkmcnt(0)" ::: "memory");
}
#define RLX_AGENT __ATOMIC_RELAXED, __HIP_MEMORY_SCOPE_AGENT
#define XB_TMO      128
#define XB_XCNT(j)  (256  + 64 * (j))
#define XB_XSUB(j)  (1280 + 64 * (j))
#define XB_XGEN(j)  (2304 + 64 * (j))
#define XB_TOP      3328
#define XB_TOPGEN   3392
#define XCD_BAR_WORDS 3456
#define XB_SPIN_CAP (1u << 18)

__device__ __forceinline__ unsigned xb_ld(unsigned* p)              { return __hip_atomic_load(p, __ATOMIC_RELAXED, __HIP_MEMORY_SCOPE_AGENT); }
__device__ __forceinline__ unsigned xb_add(unsigned* p, unsigned v) { return __hip_atomic_fetch_add(p, v, __ATOMIC_RELAXED, __HIP_MEMORY_SCOPE_AGENT); }
__device__ __forceinline__ unsigned xb_xcc_id() { return (unsigned)__builtin_amdgcn_s_getreg((3 << 11) | 20) & 0xFu; }
#define XB_SPIN(cond, bar) do { unsigned _sp = 0; while (cond) { __builtin_amdgcn_s_sleep(1); \
    if ((++_sp & 255u) == 0u) { if (xb_ld(&(bar)[XB_TMO])) break; if (_sp > XB_SPIN_CAP) { atomicAdd(&(bar)[XB_TMO], 1u); break; } } } } while (0)

struct XcdBarrier {
    unsigned* bar; unsigned x;
    volatile LAS unsigned* st;
};

__device__ __forceinline__ XcdBarrier xcd_barrier_post(unsigned* bar, volatile LAS unsigned* st) {
    XcdBarrier b; b.bar = bar; b.x = xb_xcc_id(); b.st = st;
    if (threadIdx.x == 0) (void)xb_add(&bar[XB_XCNT(b.x)], 1u);
    return b;
}
__device__ __forceinline__ void xcd_barrier_complete(unsigned* bar, unsigned x, unsigned& nloc, unsigned& nx) {
    const unsigned G = gridDim.x * gridDim.y * gridDim.z;
    unsigned sum, cnt, mine, sp = 0u;
    for (;;) {
        sum = 0u; cnt = 0u; mine = 0u;
#pragma unroll
        for (unsigned j = 0; j < 16; ++j) { const unsigned c = xb_ld(&bar[XB_XCNT(j)]); sum += c; cnt += (c > 0u) ? 1u : 0u; mine = (j == x) ? c : mine; }
        if (sum == G) break;
        __builtin_amdgcn_s_sleep(1);
        if ((++sp & 255u) == 0u) { if (xb_ld(&bar[XB_TMO])) break; if (sp > XB_SPIN_CAP) { atomicAdd(&bar[XB_TMO], 1u); break; } }
    }
    nloc = mine > 0u ? mine : 1u; nx = cnt > 0u ? cnt : 1u;
}

__device__ __forceinline__ void xcd_barrier(const XcdBarrier& b, const int wave_id) {
    asm volatile("s_waitcnt vmcnt(0)" ::: "memory");
    __syncthreads();
    if (wave_id == 0 && hw_lane_id() == 0) {
        unsigned* bar = b.bar;
        __builtin_amdgcn_s_waitcnt(0);
        unsigned nloc = b.st[0], nx = b.st[1];
        if (nloc == 0u) { xcd_barrier_complete(bar, b.x, nloc, nx); b.st[0] = nloc; b.st[1] = nx; }
        const unsigned old = xb_add(&bar[XB_XSUB(b.x)], 1u);
        const unsigned gen = old / nloc;
        if (old + 1u == (gen + 1u) * nloc) {
            __builtin_amdgcn_fence(__ATOMIC_RELEASE, "agent");
            asm volatile("s_waitcnt vmcnt(0)" ::: "memory");
            const unsigned og = xb_add(&bar[XB_TOP], 1u);
            const unsigned tg = og / nx;
            if (og + 1u == (tg + 1u) * nx) xb_add(&bar[XB_TOPGEN], 1u);
            else XB_SPIN(xb_ld(&bar[XB_TOPGEN]) == tg, bar);
            __builtin_amdgcn_fence(__ATOMIC_ACQUIRE, "agent");
            xb_add(&bar[XB_XGEN(b.x)], 1u);
            asm volatile("s_waitcnt vmcnt(0)" ::: "memory");
        } else {
            XB_SPIN(xb_ld(&bar[XB_XGEN(b.x)]) == gen, bar);
            __builtin_amdgcn_fence(__ATOMIC_ACQUIRE, "agent");
            asm volatile("s_waitcnt vmcnt(0)" ::: "memory");
        }
    }
    __syncthreads();
}

#ifndef P5_A_NT
#define P5_A_NT false
#endif
#ifndef P5_REV
#define P5_REV 1
#endif
#ifndef P4_WGM
#define P4_WGM 4
#endif
#ifndef P1_WGM
#define P1_WGM 4
#endif
#ifndef REP_P0
#define REP_P0 1
#endif
#ifndef REP_P1
#define REP_P1 1
#endif
#ifndef REP_P2
#define REP_P2 1
#endif
#ifndef REP_P2B
#define REP_P2B 1
#endif
#ifndef REP_P4
#define REP_P4 1
#endif
struct Args { const float* in[11]; float* out; unsigned char* ws; int ph_lo, ph_hi; };
constexpr int N_PHASES = 14;

__global__ void __launch_bounds__(NWAVES * 64, 2) hymba_fwd(Args args) {
    extern __shared__ __attribute__((aligned(16))) unsigned char lds[];
    cg::grid_group grid = cg::this_grid();
    const int wave = __builtin_amdgcn_readfirstlane((int)threadIdx.x >> 6);
    const int G = gridDim.x, gw = blockIdx.x * NWAVES + wave, NGW = G * NWAVES;
    const bool aff = (G == 256); const int wq = (int)(blockIdx.x >> 3) * NWAVES + wave, xb_ = (int)(blockIdx.x & 7);
    unsigned char* ws = args.ws;
    const float* x_in = args.in[0]; const float* w_in = args.in[1]; const float* conv_w = args.in[2]; const float* sinks = args.in[3];
    const float* g_mix = args.in[4]; const float* g_group = args.in[5]; const float* w_o = args.in[6]; const float* g_mlp = args.in[7];
    const float* w_ff_in = args.in[8]; const float* w_ff_out = args.in[9]; const float* g_final = args.in[10];
    float* out = args.out;
    unsigned long long* SS = (unsigned long long*)(ws + WS_SS);
    constexpr float SSQ = 1.0f / 16777216.0f;
    bf16* XB = (bf16*)(ws + WS_XB); bf16* Y = (bf16*)(ws + WS_Y); float* LSE = (float*)(ws + WS_LSE); bf16* Z = (bf16*)(ws + WS_Z);
    bf16* OA = (bf16*)(ws + WS_OA); bf16* OC = (bf16*)(ws + WS_OC); bf16* HB = (bf16*)(ws + WS_H);
    const int lo = args.ph_lo, hi = args.ph_hi;
    if (threadIdx.x < 2) ((volatile LAS unsigned*)((LAS unsigned char*)lds + LDS_BARW))[threadIdx.x] = 0u;
    __syncthreads();
    (void)xcd_barrier_post((unsigned*)(ws + WS_CTL), (volatile LAS unsigned*)((LAS unsigned char*)lds + LDS_BARW));
    if (args.ph_hi > 1000) grid.sync();
#define IN(k) (lo <= (k) && (k) < hi)
#define SEAM(k) do { if (IN(k) && IN((k) + 1)) { XcdBarrier b_; b_.bar = (unsigned*)(args.ws + WS_CTL); b_.x = xb_xcc_id(); b_.st = (volatile LAS unsigned*)((LAS unsigned char*)lds + LDS_BARW); xcd_barrier(b_, wave); } } while (0)

    if (IN(0)) for (int rep_ = 0; rep_ < REP_P0; ++rep_) {
        int tid = wave * 64 + hw_lane_id(); asm volatile("" : "+v"(tid)); const int lane = tid & 63;
        LAS float* scr = (LAS float*)((LAS unsigned char*)lds + wave * 16384);
        constexpr int I_IN = (DM / 64) * (INW / 32), I_O = (DM / 64) * (DM / 32), I_1 = (DM / 64) * (FF / 32), I_2 = (FF / 64) * (DM / 32), I_L = I_IN + I_O + I_1 + I_2;
        for (int it = gw; it < DEPTH * I_L; it += NGW) {
            const int l = it / I_L; int r = it % I_L; bf16* wb = (bf16*)(ws + WS_W + l * W_LAYER);
            if (r < I_IN) { transpose_item(w_in + (size_t)l * DM * INW, DM, INW, (bf16*)((unsigned char*)wb + W_IN), scr, r, lane, g_mix + l * DM, true); continue; } r -= I_IN;
            if (r < I_O) { transpose_item(w_o + (size_t)l * DM * DM, DM, DM, (bf16*)((unsigned char*)wb + W_O), scr, r, lane, g_group + l * DM, false); continue; } r -= I_O;
            if (r < I_1) { transpose_item(w_ff_in + (size_t)l * DM * FF, DM, FF, (bf16*)((unsigned char*)wb + W_1), scr, r, lane, g_mlp + l * DM, false); continue; } r -= I_1;
            transpose_item(w_ff_out + (size_t)l * FF * DM, FF, DM, (bf16*)((unsigned char*)wb + W_2), scr, r, lane, nullptr, false);
        }
        const int p0s = aff ? xb_ * 4096 + wq : gw, p0step = aff ? 1024 : 4 * NGW, p0u = aff ? 256 : NGW, p0e = aff ? (xb_ + 1) * 4096 : T_ROWS;
        for (int m0 = p0s; m0 < p0e; m0 += p0step) {
            f32x4 v[4][4];
#pragma unroll
            for (int u = 0; u < 4; ++u) { const int m = min(m0 + u * p0u, T_ROWS - 1); const f32x4* xr = (const f32x4*)(x_in + (size_t)m * DM) + lane;
#pragma unroll
                for (int j = 0; j < 4; ++j) v[u][j] = __builtin_nontemporal_load(xr + 64 * j); }
#pragma unroll
            for (int u = 0; u < 4; ++u) { const int m = m0 + u * p0u; if (m < T_ROWS) { float s = 0.f;
#pragma unroll
                for (int j = 0; j < 4; ++j) s += (v[u][j].x * v[u][j].x + v[u][j].y * v[u][j].y) + (v[u][j].z * v[u][j].z + v[u][j].w * v[u][j].w);
                s = wave_sum(s);
                v2u* o8 = (v2u*)(XB + (size_t)m * DM) + lane;
#pragma unroll
                for (int j = 0; j < 4; ++j) { v2u w; w.x = pk2(v[u][j].x, v[u][j].y); w.y = pk2(v[u][j].z, v[u][j].w); o8[64 * j] = w; }
                if (lane == 0) SS[m] = (unsigned long long)(s * 16777216.0f + 0.5f); } }
        }
        for (int i = blockIdx.x * 512 + tid; i < 4 * T_ROWS; i += G * 512) SS[T_ROWS + i] = 0ull;
    }
    SEAM(0);

    for (int l = 0; l < DEPTH; ++l) {
        const int pb = 1 + 6 * l;
        unsigned char* wl = ws + WS_W + l * W_LAYER;
        if (IN(pb)) for (int rep_ = 0; rep_ < REP_P1; ++rep_) {
            pg8::Gemm g{XB, (const bf16*)(wl + W_IN), T_ROWS, INW, DM}; pg8::StaticOrder S; S.init(T_ROWS, INW, G, (int)blockIdx.x, 0, P1_WGM);
            pg8::EpiScale<0> E{Z, INW, SS + (size_t)(2 * l) * T_ROWS, SSQ / DM, EPS};
            pg8::gemm_phase<pg8::EpiScale<0>, pg8::StaticOrder, true, true>((LAS unsigned char*)lds, g, S, E, wave);
        }
        SEAM(pb);
        if (IN(pb + 1)) for (int rep_ = 0; rep_ < REP_P2; ++rep_) {
            att::attn_phase(Z, OA, OC, LSE, sinks + l * 6, (char*)lds, G, T_ROWS, wave);
        }
        SEAM(pb + 1);
        if (IN(pb + 2)) for (int rep_ = 0; rep_ < REP_P2B; ++rep_) {
            const float* cw = conv_w + l * 768;
            int ln_ = hw_lane_id(); asm volatile("" : "+v"(ln_));
            const int hl = ln_ & 31, hsel = ln_ >> 5, ch = 8 * hl;
            f32x4 cwv[3][2];
#pragma unroll
            for (int i = 0; i < 3; ++i) { cwv[i][0] = *(const f32x4*)(cw + 256 * i + ch); cwv[i][1] = *(const f32x4*)(cw + 256 * i + ch + 4); }
            const int p2s = aff ? xb_ * 4096 + 2 * wq : 2 * gw, p2step = aff ? 1024 : 4 * NGW, p2u = aff ? 512 : 2 * NGW, p2e = aff ? (xb_ + 1) * 4096 : T_ROWS;
            for (int m0 = p2s; m0 < p2e; m0 += p2step) {
                v2u oa[2][3][3], oc[2][3]; float ls[2][3][3]; v4u gbv[2], gcv[2][3], xvv[2][3];
#pragma unroll
                for (int u = 0; u < 2; ++u) { const int m = min(m0 + u * p2u + hsel, T_ROWS - 1); { const int s = m & 4095; const bf16* zr = Z + (size_t)m * INW;
#pragma unroll
                    for (int j = 0; j < 3; ++j) { const int col = 128 * j + 4 * hl, hd = 2 * j + (hl >> 4);
#pragma unroll
                        for (int p = 0; p < 3; ++p) { ls[u][j][p] = LSE[((size_t)p * T_ROWS + m) * 6 + hd]; oa[u][j][p] = *(const v2u*)(OA + ((size_t)p * T_ROWS + m) * 384 + col); }
                        oc[u][j] = *(const v2u*)(OC + (size_t)m * 384 + col); }
                    gbv[u] = *(const v4u*)(zr + 1152 + ch);
#pragma unroll
                    for (int dt = 0; dt < 3; ++dt) { gcv[u][dt] = (v4u){0u, 0u, 0u, 0u}; xvv[u][dt] = (v4u){0u, 0u, 0u, 0u};
                        if (s - dt >= 0) { gcv[u][dt] = *(const v4u*)(zr - (size_t)dt * INW + 1408 + ch); xvv[u][dt] = *(const v4u*)(zr - (size_t)dt * INW + 1664 + ch); } } } }
#pragma unroll
                for (int u = 0; u < 2; ++u) { const int m = m0 + u * p2u + hsel; if (m < T_ROWS) {
                    float ya[12], yc[12], yb[8]; float ssA = 0.f, ssB = 0.f, ssC = 0.f;
#pragma unroll
                    for (int j = 0; j < 3; ++j) { const float l0 = ls[u][j][0], l1 = ls[u][j][1], l2 = ls[u][j][2];
                        const float mx = __builtin_fmaxf(__builtin_fmaxf(l0, l1), l2);
                        float w0 = __builtin_amdgcn_exp2f(l0 - mx), w1 = __builtin_amdgcn_exp2f(l1 - mx), w2 = __builtin_amdgcn_exp2f(l2 - mx);
                        const float inv = __builtin_amdgcn_rcpf(w0 + w1 + w2); w0 *= inv; w1 *= inv; w2 *= inv;
                        const v2u a0 = oa[u][j][0], a1 = oa[u][j][1], a2 = oa[u][j][2], c0 = oc[u][j];
                        ya[4 * j + 0] = w0 * bflo(a0.x) + w1 * bflo(a1.x) + w2 * bflo(a2.x); ya[4 * j + 1] = w0 * bfhi(a0.x) + w1 * bfhi(a1.x) + w2 * bfhi(a2.x);
                        ya[4 * j + 2] = w0 * bflo(a0.y) + w1 * bflo(a1.y) + w2 * bflo(a2.y); ya[4 * j + 3] = w0 * bfhi(a0.y) + w1 * bfhi(a1.y) + w2 * bfhi(a2.y);
                        yc[4 * j + 0] = bflo(c0.x); yc[4 * j + 1] = bfhi(c0.x); yc[4 * j + 2] = bflo(c0.y); yc[4 * j + 3] = bfhi(c0.y);
#pragma unroll
                        for (int e = 0; e < 4; ++e) { ssA += ya[4 * j + e] * ya[4 * j + e]; ssC += yc[4 * j + e] * yc[4 * j + e]; } }
#pragma unroll
                    for (int q = 0; q < 4; ++q) { const unsigned g = gbv[u][q];
                        const float u0l = bflo(gcv[u][0][q]) * bflo(xvv[u][0][q]), u0h = bfhi(gcv[u][0][q]) * bfhi(xvv[u][0][q]);
                        const float u1l = bflo(gcv[u][1][q]) * bflo(xvv[u][1][q]), u1h = bfhi(gcv[u][1][q]) * bfhi(xvv[u][1][q]);
                        const float u2l = bflo(gcv[u][2][q]) * bflo(xvv[u][2][q]), u2h = bfhi(gcv[u][2][q]) * bfhi(xvv[u][2][q]);
                        const int e0 = 2 * q, e1 = 2 * q + 1;
                        yb[e0] = bflo(g) * (cwv[0][e0 >> 2][e0 & 3] * u2l + cwv[1][e0 >> 2][e0 & 3] * u1l + cwv[2][e0 >> 2][e0 & 3] * u0l);
                        yb[e1] = bfhi(g) * (cwv[0][e1 >> 2][e1 & 3] * u2h + cwv[1][e1 >> 2][e1 & 3] * u1h + cwv[2][e1 >> 2][e1 & 3] * u0h);
                        ssB += yb[e0] * yb[e0] + yb[e1] * yb[e1]; }
#pragma unroll
                    for (int o = 1; o < 32; o <<= 1) { ssA += lane_xor(ssA, o); ssB += lane_xor(ssB, o); ssC += lane_xor(ssC, o); }
                    const float rA = __builtin_amdgcn_rsqf(ssA * (1.0f / 384.0f) + EPS), rB = __builtin_amdgcn_rsqf(ssB * (1.0f / 256.0f) + EPS), rC = __builtin_amdgcn_rsqf(ssC * (1.0f / 384.0f) + EPS);
                    bf16* yr = Y + (size_t)m * DM;
#pragma unroll
                    for (int j = 0; j < 3; ++j) { const int col = 128 * j + 4 * hl;
                        v2u wa; wa.x = pk2(ya[4 * j] * rA, ya[4 * j + 1] * rA); wa.y = pk2(ya[4 * j + 2] * rA, ya[4 * j + 3] * rA); *(v2u*)(yr + col) = wa;
                        v2u wc; wc.x = pk2(yc[4 * j] * rC, yc[4 * j + 1] * rC); wc.y = pk2(yc[4 * j + 2] * rC, yc[4 * j + 3] * rC); *(v2u*)(yr + 640 + col) = wc; }
                    v4u wb; wb.x = pk2(yb[0] * rB, yb[1] * rB); wb.y = pk2(yb[2] * rB, yb[3] * rB); wb.z = pk2(yb[4] * rB, yb[5] * rB); wb.w = pk2(yb[6] * rB, yb[7] * rB);
                    *(v4u*)(yr + 384 + ch) = wb; } }
            }
        }
        SEAM(pb + 2);
#ifdef PROBE_P3
        if (IN(pb + 3)) {
            pg8::Gemm g{Y, (const bf16*)(wl + W_O), T_ROWS, DM, DM}; pg8::StaticOrder S; S.init(T_ROWS, DM, G, (int)blockIdx.x);
            pg8::EpiScale<0> E{XB, DM, SS, SSQ / DM, EPS};
            pg8::gemm_phase<pg8::EpiScale<0>, pg8::StaticOrder, true, true>((LAS unsigned char*)lds, g, S, E, wave);
            grid.sync();
        }
#endif
        if (IN(pb + 3)) {
            pg8::Gemm g{Y, (const bf16*)(wl + W_O), T_ROWS, DM, DM}; pg8::StaticOrder S; S.init(T_ROWS, DM, G, (int)blockIdx.x);
            pg8::EpiResidBT<false> E{XB, SS + (size_t)(2 * l + 1) * T_ROWS, DM, nullptr, 0.f, 0.f};
            pg8::gemm_phase<pg8::EpiResidBT<false>, pg8::StaticOrder, true, true>((LAS unsigned char*)lds, g, S, E, wave);
        }
        SEAM(pb + 3);
        if (IN(pb + 4)) for (int rep_ = 0; rep_ < REP_P4; ++rep_) {
            pg8::Gemm g{XB, (const bf16*)(wl + W_1), T_ROWS, FF, DM}; pg8::StaticOrder S; S.init(T_ROWS, FF, G, (int)blockIdx.x, 0, P4_WGM);
            pg8::EpiScale<1> E{HB, FF, SS + (size_t)(2 * l + 1) * T_ROWS, SSQ / DM, EPS};
            pg8::gemm_phase<pg8::EpiScale<1>, pg8::StaticOrder, true, true>((LAS unsigned char*)lds, g, S, E, wave);
        }
        SEAM(pb + 4);
#ifdef PROBE_P5
        if (IN(pb + 5)) {
            pg8::Gemm g{HB, (const bf16*)(wl + W_2), T_ROWS, DM, FF}; pg8::StaticOrder S; S.init(T_ROWS, DM, G, (int)blockIdx.x);
            pg8::EpiScale<0> E{Y, DM, SS, SSQ / DM, EPS};
            pg8::gemm_phase<pg8::EpiScale<0>, pg8::StaticOrder, true, true>((LAS unsigned char*)lds, g, S, E, wave);
            grid.sync();
        }
#endif
        if (IN(pb + 5)) {
            pg8::Gemm g{HB, (const bf16*)(wl + W_2), T_ROWS, DM, FF}; pg8::StaticOrder S; S.init(T_ROWS, DM, G, (int)blockIdx.x, P5_REV);
            pg8::EpiResidBT<true> E{XB, SS + (size_t)(2 * l + 2) * T_ROWS, DM, SS + (size_t)(2 * l + 1) * T_ROWS, SSQ / DM, EPS};
            pg8::gemm_phase<pg8::EpiResidBT<true>, pg8::StaticOrder, true, true, P5_A_NT>((LAS unsigned char*)lds, g, S, E, wave);
        }
        SEAM(pb + 5);
    }
    if (IN(13)) {
        const unsigned long long* ssf = SS + (size_t)4 * T_ROWS;
        int lane_f = hw_lane_id(); asm volatile("" : "+v"(lane_f));
        f32x4 gv[4];
#pragma unroll
        for (int j = 0; j < 4; ++j) gv[j] = ((const f32x4*)g_final)[lane_f + 64 * j];
        const int pfs = aff ? xb_ * 4096 + wq : gw, pfstep = aff ? 1024 : 4 * NGW, pfu = aff ? 256 : NGW, pfe = aff ? (xb_ + 1) * 4096 : T_ROWS;
        for (int m0 = pfs; m0 < pfe; m0 += pfstep) {
            v2u v[4][4]; float r[4];
#pragma unroll
            for (int u = 0; u < 4; ++u) { const int m = min(m0 + u * pfu, T_ROWS - 1); const v2u* xr = (const v2u*)(XB + (size_t)m * DM) + lane_f; r[u] = (float)ssf[m];
#pragma unroll
                for (int j = 0; j < 4; ++j) v[u][j] = xr[64 * j]; }
#pragma unroll
            for (int u = 0; u < 4; ++u) { const int m = m0 + u * pfu; if (m < T_ROWS) { const float rs = __builtin_amdgcn_rsqf(r[u] * (SSQ / DM) + EPS); f32x4* orow = (f32x4*)(out + (size_t)m * DM) + lane_f;
#pragma unroll
                for (int j = 0; j < 4; ++j) __builtin_nontemporal_store((f32x4){bflo(v[u][j].x), bfhi(v[u][j].x), bflo(v[u][j].y), bfhi(v[u][j].y)} * rs * gv[j], orow + 64 * j); } }
        }
    }
#undef IN
#undef SEAM
}

#ifndef MK_N_LAUNCHES
#define MK_N_LAUNCHES 1
#endif
extern "C" void kernel_launch(void* const* d_in, const int* in_sizes, int n_in, void* d_out, int out_size, void* d_ws, size_t ws_size, hipStream_t stream) {
    static int grid = 0;
    if (grid == 0) {
        if (n_in != 11 || out_size != T_ROWS * DM || ws_size < WS_END) { fprintf(stderr, "kernel_launch: unexpected shapes (n_in %d out %d ws %zu)\n", n_in, out_size, ws_size); grid = -1; return; }
        int dev = 0, cus = 0, per_cu = 0;
        hipGetDevice(&dev); hipDeviceGetAttribute(&cus, hipDeviceAttributeMultiprocessorCount, dev);
        hipFuncSetAttribute((const void*)hymba_fwd, hipFuncAttributeMaxDynamicSharedMemorySize, LDS_BYTES);
        hipOccupancyMaxActiveBlocksPerMultiprocessor(&per_cu, (const void*)hymba_fwd, NWAVES * 64, LDS_BYTES);
        if (per_cu < 1) per_cu = 1;
        (void)hipGetLastError();
        grid = cus * per_cu;
    }
    if (grid < 0) return;
    if (MK_N_LAUNCHES == 1) (void)hipMemsetAsync((unsigned char*)d_ws + WS_CTL, 0, CTL_BYTES, stream);
    Args a{};
    for (int i = 0; i < 11; ++i) a.in[i] = (const float*)d_in[i];
    a.out = (float*)d_out; a.ws = (unsigned char*)d_ws;
    if (MK_N_LAUNCHES == 1) {
        a.ph_lo = 0; a.ph_hi = N_PHASES;
        void* kargs[] = {&a};
        hipError_t e = hipLaunchCooperativeKernel((const void*)hymba_fwd, dim3(grid), dim3(NWAVES * 64), kargs, LDS_BYTES, stream);
        if (e != hipSuccess) fprintf(stderr, "cooperative launch failed: %s (grid %d)\n", hipGetErrorString(e), grid);
    } else {
        for (int p = 0; p < N_PHASES; ++p) { a.ph_lo = p; a.ph_hi = p + 1; hipLaunchKernelGGL(hymba_fwd, dim3(grid), dim3(NWAVES * 64), LDS_BYTES, stream, a); }
    }
}
```

```cpp
#include <hip/hip_runtime.h>
#include <hip/hip_cooperative_groups.h>
#include <cstdio>
#include <cstdint>
namespace cg = cooperative_groups;
__device__ __forceinline__ int hw_lane_id() { int r; asm volatile("v_mbcnt_lo_u32_b32 %0, -1, 0\n\tv_mbcnt_hi_u32_b32 %0, -1, %0" : "=v"(r)); return r; }
__device__ __forceinline__ float lane_xor(float v, int mask) { return __uint_as_float((unsigned)__builtin_amdgcn_ds_bpermute((hw_lane_id() ^ mask) << 2, (int)__float_as_uint(v))); }
namespace pg8 {
#define PG8_LAS __attribute__((address_space(3)))
typedef unsigned short bf16_t;
typedef short bf16x8 __attribute__((ext_vector_type(8)));
typedef float f32x4 __attribute__((ext_vector_type(4)));
typedef unsigned u32x4 __attribute__((ext_vector_type(4)));
constexpr int BM = 256, BK = 64, HALF = 128, HTB = HALF * BK * 2  , STAGE_BYTES = 8 * HTB, NXCD = 8, WGM = 4;

__host__ __device__ __forceinline__ int lds_byte(int r, int c) { const int st = (r >> 4) * 2 + (c >> 5), rr = r & 15, cc = c & 31, ob = rr * 64 + cc * 2; return st * 1024 + (ob ^ (((ob >> 9) & 1) << 5)); }
__host__ __device__ __forceinline__ void stage_rc(int b, int& R, int& C) { const int st = b / 1024, sb = b % 1024, swz = sb ^ (((sb >> 9) & 1) << 5); R = (st >> 1) * 16 + swz / 64; C = (st & 1) * 32 + (swz % 64) / 2; }
__host__ __device__ __forceinline__ int perm32(int rho) { const int n = rho >> 4, i = rho & 15; return 8 * (i >> 2) + 4 * n + (i & 3); }

struct Unit { int pm, pn; };
struct Gemm { const bf16_t* A; const bf16_t* Bt; int M, N, K; };

struct StaticOrder {
    int nM, nN, nwg, G, c, rev, wgm;
    __host__ __device__ void init(int M, int N, int G_, int c_, int rev_ = 0, int wgm_ = WGM) { nM = M / BM; nN = N / BM; nwg = nM * nN; G = G_; c = c_; rev = rev_; wgm = wgm_; }
    __host__ __device__ bool next(int i, Unit& u) const {
        const int nr = (nwg + G - 1) / G; if (i >= nr) return false;
        const long L = (long)(rev ? nr - 1 - i : i) * G + c; if (L >= nwg) return false;
        int wgid = (int)L; { const int q = nwg / NXCD, r = nwg % NXCD, xcd = wgid % NXCD, off = wgid / NXCD; wgid = (xcd < r ? xcd * (q + 1) : r * (q + 1) + (xcd - r) * q) + off; }
        const int nig = wgm * nN, gid = wgid / nig, fm = gid * wgm, gsz = (nM - fm) < wgm ? (nM - fm) : wgm;
        u.pm = fm + ((wgid % nig) % gsz); u.pn = (wgid % nig) / gsz; return true;
    }
    __device__ __forceinline__ void a_ready(const Unit&) const {}
    __device__ __forceinline__ void done(const Unit&) const {}
};
__device__ __forceinline__ unsigned cvt_pk_bf16(float lo, float hi) { unsigned r; asm volatile("v_cvt_pk_bf16_f32 %0, %1, %2" : "=v"(r) : "v"(lo), "v"(hi)); return r; }
typedef float f32x2 __attribute__((ext_vector_type(2)));
#ifndef EPI_NT_Z
#define EPI_NT_Z 0
#endif
#ifndef EPI_NT_H
#define EPI_NT_H 1
#endif
#ifndef EPI_WT
#define EPI_WT 0
#endif
__device__ __forceinline__ void st16(void* base, unsigned off, u32x4 v) {
#if EPI_WT
    __amdgpu_buffer_rsrc_t r = __builtin_amdgcn_make_buffer_rsrc(base, 0, 0x7fffffff, 0x00020000);
    __builtin_amdgcn_raw_buffer_store_b128(v, r, off, 0, 16);
#else
    *(u32x4*)((char*)base + off) = v;
#endif
}
template <int ACT> struct EpiScale {
    static constexpr bool PERM = true, AFTER_DRAIN = false;
    bf16_t* O; int ldc; const unsigned long long* ss; float inv_n, eps;
    __device__ __forceinline__ void operator()(const f32x4 (&acc)[2][2][4][2], const Unit& u, int wr, int wc, int fr_, int fq_) const {
        (void)fr_; (void)fq_; const int ln_ = hw_lane_id(); const int fr = ln_ & 15, fq = ln_ >> 4;
        const int row0 = u.pm * BM + wr * 64 + fr; const int col0 = u.pn * BM + wc * 64 + 8 * fq;
        float rr[2][4];
        if (ACT == 0) { unsigned long long sv[2][4];
#pragma unroll
            for (int ai = 0; ai < 2; ++ai)
#pragma unroll
                for (int m = 0; m < 4; ++m) sv[ai][m] = ss[row0 + ai * HALF + m * 16];
#pragma unroll
            for (int ai = 0; ai < 2; ++ai)
#pragma unroll
                for (int m = 0; m < 4; ++m) rr[ai][m] = __builtin_amdgcn_rsqf((float)sv[ai][m] * inv_n + eps);
            asm volatile("" : "+v"(rr[0][0]), "+v"(rr[0][1]), "+v"(rr[0][2]), "+v"(rr[0][3]), "+v"(rr[1][0]), "+v"(rr[1][1]), "+v"(rr[1][2]), "+v"(rr[1][3])); }
#pragma unroll
        for (int ai = 0; ai < 2; ++ai)
#pragma unroll
            for (int m = 0; m < 4; ++m) { const int row = row0 + ai * HALF + m * 16; float r = 1.f; if (ACT == 0) r = rr[ai][m];
#pragma unroll
                for (int bj = 0; bj < 2; ++bj) { f32x4 v0 = acc[ai][bj][m][0], v1 = acc[ai][bj][m][1];
                    if (ACT == 0) { v0 = v0 * r; v1 = v1 * r; }
                    else {
#pragma unroll
                        for (int e = 0; e < 4; ++e) { v0[e] = __builtin_fmaxf(v0[e], 0.f); v1[e] = __builtin_fmaxf(v1[e], 0.f); }
                        v0 = v0 * v0; v1 = v1 * v1; }
                    u32x4 w; w.x = cvt_pk_bf16(v0[0], v0[1]); w.y = cvt_pk_bf16(v0[2], v0[3]); w.z = cvt_pk_bf16(v1[0], v1[1]); w.w = cvt_pk_bf16(v1[2], v1[3]);
                    if ((ACT == 1 || EPI_NT_Z) && EPI_NT_H) __builtin_nontemporal_store(w, (u32x4*)(O + (size_t)row * ldc + col0 + bj * 32));
                    else st16(O, (unsigned)(((size_t)row * ldc + col0 + bj * 32) * 2), w); } }
    }
};
struct EpiResid {
    static constexpr bool PERM = true, AFTER_DRAIN = false;
    const float* base; float* out; bf16_t* xb; float* ss_out; int ldc;
    __device__ __forceinline__ void operator()(const f32x4 (&acc)[2][2][4][2], const Unit& u, int wr, int wc, int fr_, int fq_) const {
        (void)fr_; (void)fq_; const int ln_ = hw_lane_id(); const int fr = ln_ & 15, fq = ln_ >> 4;
        const int row0 = u.pm * BM + wr * 64 + fr; const int col0 = u.pn * BM + wc * 64 + 8 * fq;
#pragma unroll
        for (int ai = 0; ai < 2; ++ai)
#pragma unroll
            for (int m = 0; m < 4; ++m) { const int row = row0 + ai * HALF + m * 16; const size_t off = (size_t)row * ldc + col0; float s = 0.f;
#pragma unroll
                for (int bj = 0; bj < 2; ++bj) { const f32x4 b0 = *(const f32x4*)(base + off + bj * 32), b1 = *(const f32x4*)(base + off + bj * 32 + 4);
                    const f32x4 v0 = acc[ai][bj][m][0] + b0, v1 = acc[ai][bj][m][1] + b1;
                    *(f32x4*)(out + off + bj * 32) = v0; *(f32x4*)(out + off + bj * 32 + 4) = v1;
                    u32x4 w; w.x = cvt_pk_bf16(v0[0], v0[1]); w.y = cvt_pk_bf16(v0[2], v0[3]); w.z = cvt_pk_bf16(v1[0], v1[1]); w.w = cvt_pk_bf16(v1[2], v1[3]);
                    *(u32x4*)(xb + off + bj * 32) = w;
                    s += (v0[0] * v0[0] + v0[1] * v0[1]) + (v0[2] * v0[2] + v0[3] * v0[3]) + (v1[0] * v1[0] + v1[1] * v1[1]) + (v1[2] * v1[2] + v1[3] * v1[3]); }
                s += lane_xor(s, 16); s += lane_xor(s, 32);
                if (fq == 0) unsafeAtomicAdd(ss_out + row, s); }
    }
};
template <bool SCALE> struct EpiResidBT {
    static constexpr bool PERM = true, AFTER_DRAIN = false;
    bf16_t* xb; unsigned long long* ss_out; int ldc; const unsigned long long* ss_in; float inv_n, eps;
    __device__ __forceinline__ void operator()(const f32x4 (&acc)[2][2][4][2], const Unit& u, int wr, int wc, int fr_, int fq_) const {
        (void)fr_; (void)fq_; const int ln_ = hw_lane_id(); const int fr = ln_ & 15, fq = ln_ >> 4;
        const int row0 = u.pm * BM + wr * 64 + fr; const int col0 = u.pn * BM + wc * 64 + 8 * fq;
        float sacc[2][4];
#pragma unroll
        for (int ai = 0; ai < 2; ++ai) {
            u32x4 rb[4][2]; unsigned long long sv[4];
#pragma unroll
            for (int m = 0; m < 4; ++m) { const int row = row0 + ai * HALF + m * 16; const bf16_t* p = xb + (size_t)row * ldc + col0;
                rb[m][0] = *(const u32x4*)(p); rb[m][1] = *(const u32x4*)(p + 32); if (SCALE) sv[m] = ss_in[row]; }
#pragma unroll
            for (int m = 0; m < 4; ++m) { const int row = row0 + ai * HALF + m * 16; f32x2 s2 = (f32x2){0.f, 0.f};
                float r2 = 1.f; if (SCALE) r2 = __builtin_amdgcn_rcpf((float)sv[m] * inv_n + eps);
#pragma unroll
                for (int bj = 0; bj < 2; ++bj) { const u32x4 b = rb[m][bj];
                    const f32x4 b0 = (f32x4){__uint_as_float(b.x << 16), __uint_as_float(b.x & 0xffff0000u), __uint_as_float(b.y << 16), __uint_as_float(b.y & 0xffff0000u)};
                    const f32x4 b1 = (f32x4){__uint_as_float(b.z << 16), __uint_as_float(b.z & 0xffff0000u), __uint_as_float(b.w << 16), __uint_as_float(b.w & 0xffff0000u)};
                    f32x4 v0, v1;
                    if (SCALE) { v0 = acc[ai][bj][m][0] * r2 + b0; v1 = acc[ai][bj][m][1] * r2 + b1; } else { v0 = acc[ai][bj][m][0] + b0; v1 = acc[ai][bj][m][1] + b1; }
                    u32x4 w; w.x = cvt_pk_bf16(v0[0], v0[1]); w.y = cvt_pk_bf16(v0[2], v0[3]); w.z = cvt_pk_bf16(v1[0], v1[1]); w.w = cvt_pk_bf16(v1[2], v1[3]);
                    st16(xb, (unsigned)(((size_t)row * ldc + col0 + bj * 32) * 2), w);
                    s2 = __builtin_elementwise_fma((f32x2){v0[0], v0[1]}, (f32x2){v0[0], v0[1]}, s2); s2 = __builtin_elementwise_fma((f32x2){v0[2], v0[3]}, (f32x2){v0[2], v0[3]}, s2);
                    s2 = __builtin_elementwise_fma((f32x2){v1[0], v1[1]}, (f32x2){v1[0], v1[1]}, s2); s2 = __builtin_elementwise_fma((f32x2){v1[2], v1[3]}, (f32x2){v1[2], v1[3]}, s2); }
                float s = s2.x + s2.y;
                s += lane_xor(s, 16); s += lane_xor(s, 32);
                sacc[ai][m] = s; }
        }
        if (fq == 0) {
#pragma unroll
            for (int ai = 0; ai < 2; ++ai)
#pragma unroll
                for (int m = 0; m < 4; ++m) atomicAdd(ss_out + row0 + ai * HALF + m * 16, (unsigned long long)(sacc[ai][m] * 16777216.0f + 0.5f)); }
    }
};
template <class Epi, class Sched, bool ALIGN_EPI = false, bool SP2 = false, bool A_NT = false>
__device__ __forceinline__ void gemm_phase(PG8_LAS unsigned char* lds, const Gemm g, const Sched& S, const Epi& E, const int wave_id) {
    int tid_ = wave_id * 64 + hw_lane_id(); asm volatile("" : "+v"(tid_));
    const int tid = tid_, wid = __builtin_amdgcn_readfirstlane(tid >> 6), lane = tid & 63, wr = wid >> 2, wc = wid & 3, fr = lane & 15, fq = lane >> 4;
    const int K = g.K, nt = K / BK;
    constexpr int aux_voffA = A_NT ? 2 : 0, aux_voffB = 0;
    unsigned voffA[2], voffB[2];
#pragma unroll
    for (int i = 0; i < 2; ++i) { int R, C; stage_rc(tid * 16 + i * 8192, R, C); const int Rb = Epi::PERM ? (64 * (R >> 5) + perm32(R & 31)) : R;
        voffA[i] = (unsigned)(R * K + C) * 2u; voffB[i] = (unsigned)(Rb * K + C) * 2u; }
    const size_t kstep = (size_t)(BK * 2);
    const size_t hstep = (size_t)HALF * K * 2;
    const size_t hstepB = Epi::PERM ? (size_t)32 * K * 2 : hstep;
    const size_t tstep = 2 * hstep;
    const unsigned ldsw = (unsigned)wid * 1024u;
    const int aoff = lds_byte(wr * 64 + fr, fq * 8), boff = lds_byte(wc * 32 + fr, fq * 8);
#define PG8_SA(b, h) (((b) * 2 + (h)) * HTB)
#define PG8_SB(b, h) ((4 + (b) * 2 + (h)) * HTB)
#define PG8_STAGE(bufoff, gbase, voff) do { _Pragma("unroll") for (int _i = 0; _i < 2; ++_i) \
        __builtin_amdgcn_global_load_lds((const unsigned*)((const char*)(gbase) + (voff)[_i]), (PG8_LAS unsigned*)(lds + (bufoff) + ldsw + _i * 8192), 16, 0, aux_##voff); } while (0)
#define PG8_LDA(dst, b, h) do { _Pragma("unroll") for (int m = 0; m < 4; ++m) _Pragma("unroll") for (int k = 0; k < 2; ++k) dst[m][k] = *(const PG8_LAS bf16x8*)(lds + PG8_SA(b, h) + aoff + m * 2048 + k * 1024); } while (0)
#define PG8_LDB(dst, b, h) do { _Pragma("unroll") for (int n = 0; n < 2; ++n) _Pragma("unroll") for (int k = 0; k < 2; ++k) dst[n][k] = *(const PG8_LAS bf16x8*)(lds + PG8_SB(b, h) + boff + n * 2048 + k * 1024); } while (0)
#define PG8_MMA(ai, bj, At, Bt) do { __builtin_amdgcn_s_setprio(1); _Pragma("unroll") for (int m = 0; m < 4; ++m) _Pragma("unroll") for (int n = 0; n < 2; ++n) _Pragma("unroll") for (int k = 0; k < 2; ++k) \
        acc[ai][bj][m][n] = __builtin_amdgcn_mfma_f32_16x16x32_bf16(Bt[n][k], At[m][k], acc[ai][bj][m][n], 0, 0, 0); __builtin_amdgcn_s_setprio(0); } while (0)
#define PG8_WAIT_V(n) asm volatile("s_waitcnt vmcnt(" #n ")" ::: "memory")
#define PG8_WAIT_L(n) asm volatile("s_waitcnt lgkmcnt(" #n ")" ::: "memory")
#define PG8_BAR __builtin_amdgcn_s_barrier()
#define PG8_SCHED __builtin_amdgcn_sched_barrier(0)
    Unit cur, nxt; int ui = 0;
    if (!S.next(0, cur)) return;
    f32x4 acc[2][2][4][2];
#pragma unroll
    for (int a = 0; a < 2; ++a)
#pragma unroll
        for (int b = 0; b < 2; ++b)
#pragma unroll
            for (int m = 0; m < 4; ++m)
#pragma unroll
                for (int n = 0; n < 2; ++n) acc[a][b][m][n] = (f32x4){0.f, 0.f, 0.f, 0.f};
    bf16x8 At[4][2], B0[2][2], B1[2][2];
    const char* cA = (const char*)g.A + (size_t)cur.pm * tstep; const char* cB = (const char*)g.Bt + (size_t)cur.pn * tstep;
    S.a_ready(cur);
    if constexpr (SP2) {
        PG8_STAGE(PG8_SB(0, 0), cB, voffB); PG8_STAGE(PG8_SB(0, 1), cB + hstepB, voffB); PG8_STAGE(PG8_SA(0, 0), cA, voffA); PG8_STAGE(PG8_SA(0, 1), cA + hstep, voffA);
        if (wr == 1) PG8_BAR;
        PG8_WAIT_V(2); PG8_BAR;
        PG8_STAGE(PG8_SB(1, 0), cB + kstep, voffB); PG8_STAGE(PG8_SA(1, 0), cA + kstep, voffA); PG8_STAGE(PG8_SB(1, 1), cB + hstepB + kstep, voffB);
        PG8_WAIT_V(6); PG8_BAR;
    } else {
        PG8_STAGE(PG8_SB(0, 0), cB, voffB); PG8_STAGE(PG8_SA(0, 0), cA, voffA); PG8_STAGE(PG8_SB(0, 1), cB + hstepB, voffB); PG8_STAGE(PG8_SA(0, 1), cA + hstep, voffA);
        if (wr == 1) PG8_BAR;
        PG8_WAIT_V(4); PG8_BAR;
        PG8_STAGE(PG8_SB(1, 0), cB + kstep, voffB); PG8_STAGE(PG8_SA(1, 0), cA + kstep, voffA); PG8_STAGE(PG8_SB(1, 1), cB + hstepB + kstep, voffB);
        PG8_WAIT_V(6); PG8_BAR;
    }
    for (;;) {
        const bool has_next = S.next(ui + 1, nxt);
        const char* nA = has_next ? (const char*)g.A + (size_t)nxt.pm * tstep : cA; const char* nB = has_next ? (const char*)g.Bt + (size_t)nxt.pn * tstep : cB;
        for (int t = 0; t < nt; t += 2) {
            const bool last = (t == nt - 2);
            const char* a1 = cA + (size_t)(t + 1) * kstep;
            const char* a2 = last ? nA : cA + (size_t)(t + 2) * kstep; const char* b2 = last ? nB : cB + (size_t)(t + 2) * kstep;
            const char* a3 = a2 + kstep; const char* b3 = b2 + kstep;
            if (last && has_next) S.a_ready(nxt);
            if constexpr (SP2) {
            PG8_LDB(B0, 0, 0); PG8_LDB(B1, 0, 1); PG8_SCHED; PG8_LDA(At, 0, 0); PG8_STAGE(PG8_SA(1, 1), a1 + hstep, voffA);
            PG8_WAIT_V(8); PG8_WAIT_L(0); PG8_BAR; PG8_MMA(0, 0, At, B0); PG8_MMA(0, 1, At, B1); PG8_BAR; PG8_SCHED;
            PG8_LDA(At, 0, 1); PG8_STAGE(PG8_SB(0, 0), b2, voffB); PG8_STAGE(PG8_SB(0, 1), b2 + hstepB, voffB); PG8_STAGE(PG8_SA(0, 0), a2, voffA);
            PG8_WAIT_V(8); PG8_WAIT_L(0); PG8_BAR; PG8_MMA(1, 0, At, B0); PG8_MMA(1, 1, At, B1); PG8_BAR; PG8_SCHED;
            PG8_LDB(B0, 1, 0); PG8_LDB(B1, 1, 1); PG8_SCHED; PG8_LDA(At, 1, 0); PG8_STAGE(PG8_SA(0, 1), a2 + hstep, voffA);
            PG8_WAIT_V(8); PG8_WAIT_L(0); PG8_BAR; PG8_MMA(0, 0, At, B0); PG8_MMA(0, 1, At, B1); PG8_BAR; PG8_SCHED;
            PG8_LDA(At, 1, 1); PG8_STAGE(PG8_SB(1, 0), b3, voffB); PG8_STAGE(PG8_SB(1, 1), b3 + hstepB, voffB); PG8_STAGE(PG8_SA(1, 0), a3, voffA);
            PG8_WAIT_V(8); PG8_WAIT_L(0); PG8_BAR; PG8_MMA(1, 0, At, B0); PG8_MMA(1, 1, At, B1); PG8_BAR; PG8_SCHED;
            } else {
            PG8_LDB(B0, 0, 0); PG8_SCHED; PG8_LDA(At, 0, 0); PG8_STAGE(PG8_SA(1, 1), a1 + hstep, voffA);
            PG8_WAIT_L(8); PG8_BAR; PG8_WAIT_L(0); PG8_MMA(0, 0, At, B0); PG8_BAR; PG8_SCHED;
            PG8_LDB(B1, 0, 1); PG8_STAGE(PG8_SB(0, 0), b2, voffB);
            PG8_BAR; PG8_WAIT_L(0); PG8_MMA(0, 1, At, B1); PG8_BAR;
            PG8_LDA(At, 0, 1); PG8_STAGE(PG8_SA(0, 0), a2, voffA);
            PG8_BAR; PG8_WAIT_L(0); PG8_MMA(1, 0, At, B0); PG8_BAR; PG8_SCHED;
            PG8_STAGE(PG8_SB(0, 1), b2 + hstepB, voffB);
            PG8_WAIT_V(6); PG8_BAR; PG8_MMA(1, 1, At, B1); PG8_BAR;
            PG8_LDB(B0, 1, 0); PG8_SCHED; PG8_LDA(At, 1, 0); PG8_STAGE(PG8_SA(0, 1), a2 + hstep, voffA);
            PG8_WAIT_L(8); PG8_BAR; PG8_WAIT_L(0); PG8_MMA(0, 0, At, B0); PG8_BAR; PG8_SCHED;
            PG8_LDB(B1, 1, 1); PG8_STAGE(PG8_SB(1, 0), b3, voffB);
            PG8_BAR; PG8_WAIT_L(0); PG8_MMA(0, 1, At, B1); PG8_BAR;
            PG8_LDA(At, 1, 1); PG8_STAGE(PG8_SA(1, 0), a3, voffA);
            PG8_BAR; PG8_WAIT_L(0); PG8_MMA(1, 0, At, B0); PG8_BAR; PG8_SCHED;
            PG8_STAGE(PG8_SB(1, 1), b3 + hstepB, voffB);
            PG8_WAIT_V(6); PG8_BAR; PG8_MMA(1, 1, At, B1); PG8_BAR;
            }
        }
        if constexpr (ALIGN_EPI) { if (wr == 0) PG8_BAR; }
        if constexpr (!Epi::AFTER_DRAIN) { E(acc, cur, wr, wc, fr, fq); S.done(cur); }
        if (!has_next) break;
#pragma unroll
        for (int a = 0; a < 2; ++a)
#pragma unroll
            for (int b = 0; b < 2; ++b)
#pragma unroll
                for (int m = 0; m < 4; ++m)
#pragma unroll
                    for (int n = 0; n < 2; ++n) acc[a][b][m][n] = (f32x4){0.f, 0.f, 0.f, 0.f};
        cur = nxt; cA = nA; cB = nB; ++ui;
        if constexpr (ALIGN_EPI) { if (wr == 1) PG8_BAR; }
    }
    PG8_WAIT_V(0);
    if constexpr (!ALIGN_EPI) { if (wr == 0) PG8_BAR; }
    PG8_BAR;
    if constexpr (Epi::AFTER_DRAIN) { E.fused(acc, cur, wr, wc, fr, fq, lds, wid, lane); S.done(cur); }
#undef PG8_SA
#undef PG8_SB
#undef PG8_STAGE
#undef PG8_LDA
#undef PG8_LDB
#undef PG8_MMA
#undef PG8_WAIT_V
#undef PG8_WAIT_L
#undef PG8_BAR
#undef PG8_SCHED
}
}
namespace att {
typedef unsigned short bf16_t;
typedef short bf16x8 __attribute__((ext_vector_type(8)));
typedef short s16x4 __attribute__((ext_vector_type(4)));
typedef float f32x16 __attribute__((ext_vector_type(16)));
typedef unsigned u32x4 __attribute__((ext_vector_type(4)));
#define ALAS __attribute__((address_space(3)))
constexpr int ZP = 2560;
constexpr int KCS = 6160;
constexpr int VDH = 24576;
constexpr int LDS_K = 0, LDS_V = 8 * KCS  , LDS_WS = LDS_V + 2 * VDH  , LDS_OST = LDS_WS + 8 * 256  , LDS_END = LDS_OST + 8 * 4096;
__device__ __forceinline__ int crow(int r, int hi) { return (r & 3) + 8 * (r >> 2) + 4 * hi; }
__device__ __forceinline__ unsigned cvtpk(float lo, float hi) { unsigned r; asm volatile("v_cvt_pk_bf16_f32 %0, %1, %2" : "=v"(r) : "v"(lo), "v"(hi)); return r; }
__device__ __forceinline__ float swapmax(float m) { auto rr = __builtin_amdgcn_permlane32_swap(__float_as_uint(m), __float_as_uint(m), false, false); return __builtin_fmaxf(__uint_as_float(rr[0]), __uint_as_float(rr[1])); }
__device__ __forceinline__ float swapsum(float m) { auto rr = __builtin_amdgcn_permlane32_swap(__float_as_uint(m), __float_as_uint(m), false, false); return __uint_as_float(rr[0]) + __uint_as_float(rr[1]); }
template <int OFF> __device__ __forceinline__ void pv32(f32x16* o, int vb, bf16x8 pa0, bf16x8 pa1) {
#pragma unroll
    for (int d0 = 0; d0 < 2; ++d0) { s16x4 lo[2], hi[2];
#pragma unroll
        for (int ks = 0; ks < 2; ++ks) {
            asm volatile("ds_read_b64_tr_b16 %0,%1 offset:%c2" : "=&v"(lo[ks]) : "v"(vb), "i"(d0 * VDH + OFF + ks * 1024) : "memory");
            asm volatile("ds_read_b64_tr_b16 %0,%1 offset:%c2" : "=&v"(hi[ks]) : "v"(vb), "i"(d0 * VDH + OFF + ks * 1024 + 512) : "memory"); }
        asm volatile("s_waitcnt lgkmcnt(0)" ::: "memory"); __builtin_amdgcn_sched_barrier(0);
#define PK(k) (bf16x8){lo[k][0], lo[k][1], lo[k][2], lo[k][3], hi[k][0], hi[k][1], hi[k][2], hi[k][3]}
        o[d0] = __builtin_amdgcn_mfma_f32_32x32x16_bf16(pa0, PK(0), o[d0], 0, 0, 0);
        o[d0] = __builtin_amdgcn_mfma_f32_32x32x16_bf16(pa1, PK(1), o[d0], 0, 0, 0);
#undef PK
    }
}
struct UnitP { int kind, h, dil, q0, qb, qcol, kcol, vcol; long rowb; };
__device__ __forceinline__ UnitP decode(int u) {
    UnitP p; int b, idx16;
    if (u < 2304) { idx16 = u & 15; p.h = (u >> 4) % 6; const int kb = u / 96; p.kind = kb % 3; b = kb / 3; }
    else { const int u3 = u - 2304, g = u3 >> 8, rest = u3 & 255; idx16 = rest & 15; const int kvh = (rest >> 4) & 1; b = rest >> 5; p.h = 3 * kvh + g; p.kind = 3; }
    const int lg = (p.kind == 1) ? 2 : (p.kind == 2) ? 4 : 0; p.dil = 1 << lg;
    const int res = idx16 & (p.dil - 1); p.qb = idx16 >> lg; p.q0 = p.qb * 256;
    p.qcol = (p.kind < 3 ? 0 : 1920) + p.h * 64; p.kcol = (p.kind < 3) ? 384 + p.h * 64 : 2304 + (p.h / 3) * 64; p.vcol = (p.kind < 3) ? 768 + p.h * 64 : 2432 + (p.h / 3) * 64;
    p.rowb = (long)b * 4096 + res; return p;
}
__device__ __forceinline__ void issue_loads(const UnitP& p, const bf16_t* __restrict__ Z, int tid, int wid, int r32, int hi, u32x4 (&kr)[6], u32x4 (&vr)[6], bf16x8 (&qn)[4]) {
    const __amdgpu_buffer_rsrc_t rz = __builtin_amdgcn_make_buffer_rsrc((void*)Z, 0, 32768 * ZP * 2, 0x00020000);
    const int kk0 = tid >> 3, c8 = tid & 7;
    const int rowb = (int)p.rowb;
#pragma unroll
    for (int j = 0; j < 6; ++j) { int sj = p.q0 - 128 + 64 * j; asm volatile("" : "+s"(sj));
        const int kpos = kk0 + sj;
        const unsigned rofs = (unsigned)((rowb + p.dil * kpos) * ZP + c8 * 8) * 2u;
        const unsigned ko = kpos >= 0 ? rofs + (unsigned)p.kcol * 2u : 0xFFFFFFFFu, vo = kpos >= 0 ? rofs + (unsigned)p.vcol * 2u : 0xFFFFFFFFu;
        kr[j] = __builtin_amdgcn_raw_buffer_load_b128(rz, ko, 0, 0); vr[j] = __builtin_amdgcn_raw_buffer_load_b128(rz, vo, 0, 0); }
    const int ql = tid & 63;
#pragma unroll
    for (int i = 0; i < 4; ++i) { const int rq = rowb + p.dil * (p.q0 + 32 * wid + 8 * i + (ql >> 3)); qn[i] = __builtin_bit_cast(bf16x8, (u32x4)__builtin_amdgcn_raw_buffer_load_b128(rz, (unsigned)(rq * ZP + p.qcol + (ql & 7) * 8) * 2u, 0, 0)); }
    (void)r32; (void)hi;
}
__device__ __forceinline__ void attn_phase(const bf16_t* __restrict__ Z, bf16_t* __restrict__ OA, bf16_t* __restrict__ OC, float* __restrict__ LSEb, const float* __restrict__ sinks_l, char* shm, int G, int T_ROWS, const int wave_id) {
    int tid_ = wave_id * 64 + hw_lane_id(); asm volatile("" : "+v"(tid_));
    const int tid = tid_, lane = tid & 63, r32 = lane & 31, hi = lane >> 5; const int wid = __builtin_amdgcn_readfirstlane(tid >> 6);
    ALAS char* sh = (ALAS char*)shm;
    int u = (G % 8 == 0) ? (int)(blockIdx.x % 8) * (G / 8) + (int)(blockIdx.x / 8) : (int)blockIdx.x; if (u >= 3072) return;
    float sk[6];
#pragma unroll
    for (int i = 0; i < 6; ++i) sk[i] = __uint_as_float(__builtin_amdgcn_readfirstlane(__float_as_uint(sinks_l[i] * 1.4426950408889634f)));
    u32x4 kr[6], vr[6]; bf16x8 qn[4];
    { const UnitP p0 = decode(u); issue_loads(p0, Z, tid, wid, r32, hi, kr, vr, qn); }
    for (;;) {
        const UnitP up = decode(u);
        bf16_t* __restrict__ O = (up.kind < 3) ? OA + (size_t)up.kind * T_ROWS * 384 : OC;
        float* __restrict__ LSE = LSEb + (size_t)up.kind * T_ROWS * 6;
        const float sink2 = (up.kind == 3) ? sk[up.h] : 0.f;
        const int kind = up.kind, h = up.h, dil = up.dil, q0 = up.q0, qb = up.qb; const long rowb = up.rowb;
        const long rowq = rowb + (long)dil * (q0 + 32 * wid + r32);
        bf16x8 qr[4];
#pragma unroll
        for (int i = 0; i < 4; ++i) { const int row = 8 * i + (lane >> 3); *(ALAS bf16x8*)(sh + LDS_OST + wid * 4096 + row * 128 + (((lane & 7) ^ (row & 7)) * 16)) = qn[i]; }
        asm volatile("s_waitcnt lgkmcnt(0)" ::: "memory");
#pragma unroll
        for (int d0 = 0; d0 < 4; ++d0) qr[d0] = *(ALAS const bf16x8*)(sh + LDS_OST + wid * 4096 + r32 * 128 + (((2 * d0 + hi) ^ (r32 & 7)) * 16));
#pragma unroll
        for (int j = 0; j < 6; ++j) { const int i = tid + 512 * j, kk = i >> 3, c8 = i & 7;
            *(ALAS u32x4*)(sh + LDS_K + c8 * KCS + kk * 16) = kr[j];
            *(ALAS u32x4*)(sh + LDS_V + (c8 >> 2) * VDH + (kk >> 4) * 1024 + (kk & 15) * 64 + (c8 & 3) * 16) = vr[j]; }
        __syncthreads();
        const int un = u + G;
        if (un < 3072) { const UnitP pn = decode(un); issue_loads(pn, Z, tid, wid, r32, hi, kr, vr, qn); }
        asm volatile("" ::: "memory");
        f32x16 p[5];
        { const int kaddr = (int)(unsigned)(uintptr_t)(shm + LDS_K) + hi * KCS + (32 * wid + r32) * 16;
#define KRD(dst, OFF) asm volatile("ds_read_b128 %0, %1 offset:%c2" : "=&v"(dst) : "v"(kaddr), "i"(OFF) : "memory")
#define KRD4(F, BLK) do { KRD(F[0], 0 * 2 * KCS + (BLK) * 512); KRD(F[1], 1 * 2 * KCS + (BLK) * 512); KRD(F[2], 2 * 2 * KCS + (BLK) * 512); KRD(F[3], 3 * 2 * KCS + (BLK) * 512); } while (0)
#define QK2(PA, FA, PB, FB) do { f32x16 z_ = {}; \
            PA = __builtin_amdgcn_mfma_f32_32x32x16_bf16(FA[0], qr[0], z_, 0, 0, 0); PB = __builtin_amdgcn_mfma_f32_32x32x16_bf16(FB[0], qr[0], z_, 0, 0, 0); \
            PA = __builtin_amdgcn_mfma_f32_32x32x16_bf16(FA[1], qr[1], PA, 0, 0, 0); PB = __builtin_amdgcn_mfma_f32_32x32x16_bf16(FB[1], qr[1], PB, 0, 0, 0); \
            PA = __builtin_amdgcn_mfma_f32_32x32x16_bf16(FA[2], qr[2], PA, 0, 0, 0); PB = __builtin_amdgcn_mfma_f32_32x32x16_bf16(FB[2], qr[2], PB, 0, 0, 0); \
            PA = __builtin_amdgcn_mfma_f32_32x32x16_bf16(FA[3], qr[3], PA, 0, 0, 0); PB = __builtin_amdgcn_mfma_f32_32x32x16_bf16(FB[3], qr[3], PB, 0, 0, 0); } while (0)
          bf16x8 f0[4], f1[4];
          KRD4(f0, 0); KRD4(f1, 1);
          asm volatile("s_waitcnt lgkmcnt(0)" ::: "memory"); __builtin_amdgcn_sched_barrier(0);
          QK2(p[0], f0, p[1], f1);
          __builtin_amdgcn_sched_barrier(0);
          KRD4(f0, 2); KRD4(f1, 3);
          asm volatile("s_waitcnt lgkmcnt(0)" ::: "memory"); __builtin_amdgcn_sched_barrier(0);
          QK2(p[2], f0, p[3], f1);
          __builtin_amdgcn_sched_barrier(0);
          KRD4(f0, 4);
          asm volatile("s_waitcnt lgkmcnt(0)" ::: "memory"); __builtin_amdgcn_sched_barrier(0);
          { f32x16 z_ = {}; p[4] = __builtin_amdgcn_mfma_f32_32x32x16_bf16(f0[0], qr[0], z_, 0, 0, 0);
            p[4] = __builtin_amdgcn_mfma_f32_32x32x16_bf16(f0[1], qr[1], p[4], 0, 0, 0); p[4] = __builtin_amdgcn_mfma_f32_32x32x16_bf16(f0[2], qr[2], p[4], 0, 0, 0); p[4] = __builtin_amdgcn_mfma_f32_32x32x16_bf16(f0[3], qr[3], p[4], 0, 0, 0); }
#undef KRD
#undef KRD4
#undef QK2
        }
        const float NEG = -INFINITY; const int lo_thr = r32 + (kind == 3 ? 1 : 0);
#pragma unroll
        for (int r = 0; r < 16; ++r) { const int cr = crow(r, hi); if (cr < lo_thr) p[0][r] = NEG; if (cr > r32) p[4][r] = NEG; }
        const int nskip = (qb == 0) ? 4 - wid : 0;
        float m = p[4][0];
#pragma unroll
        for (int blk = 0; blk < 5; ++blk) if (blk >= nskip) {
#pragma unroll
            for (int r = 0; r < 16; ++r) m = __builtin_fmaxf(m, p[blk][r]); }
        m = swapmax(m);
        if (kind == 3) m = __builtin_fmaxf(m, sink2);
        float l = 0.f;
        { typedef float f2 __attribute__((ext_vector_type(2))); const f2 mm = (f2){m, m}; f2 ls = (f2){0.f, 0.f};
#pragma unroll
          for (int blk = 0; blk < 5; ++blk) {
            if (blk >= nskip) {
#pragma unroll
              for (int r = 0; r < 16; r += 2) { const f2 d = (f2){p[blk][r], p[blk][r + 1]} - mm; f2 e; e.x = __builtin_amdgcn_exp2f(d.x); e.y = __builtin_amdgcn_exp2f(d.y); p[blk][r] = e.x; p[blk][r + 1] = e.y; ls += e; }
            } else {
#pragma unroll
              for (int r = 0; r < 16; ++r) p[blk][r] = 0.f; } }
          l = ls.x + ls.y; }
        l = swapsum(l);
        if (kind == 3) l += __builtin_amdgcn_exp2f(sink2 - m);
        f32x16 o[2]; o[0] = f32x16{}; o[1] = f32x16{};
        const int vb = (int)(unsigned)(uintptr_t)(shm + LDS_V) + (2 * wid) * 1024 + ((lane >> 4) & 1) * 32 + (lane & 3) * 8 + (4 * hi + ((lane & 15) >> 2)) * 64;
#define PA(P, B) __builtin_bit_cast(bf16x8, (u32x4){cvtpk(P[B], P[B + 1]), cvtpk(P[B + 2], P[B + 3]), cvtpk(P[B + 4], P[B + 5]), cvtpk(P[B + 6], P[B + 7])})
#define VRD(dst, OFF) asm volatile("ds_read_b64_tr_b16 %0,%1 offset:%c2" : "=&v"(dst) : "v"(vb), "i"(OFF) : "memory")
#define VRD8(L, H, BLK) do { VRD(L[0], 0 * VDH + (BLK) * 2048); VRD(H[0], 0 * VDH + (BLK) * 2048 + 512); VRD(L[1], 0 * VDH + (BLK) * 2048 + 1024); VRD(H[1], 0 * VDH + (BLK) * 2048 + 1536); \
                             VRD(L[2], 1 * VDH + (BLK) * 2048); VRD(H[2], 1 * VDH + (BLK) * 2048 + 512); VRD(L[3], 1 * VDH + (BLK) * 2048 + 1024); VRD(H[3], 1 * VDH + (BLK) * 2048 + 1536); } while (0)
#define VF(L, H, k) (bf16x8){L[k][0], L[k][1], L[k][2], L[k][3], H[k][0], H[k][1], H[k][2], H[k][3]}
#define PV4(P, L, H) do { const bf16x8 a0_ = PA(P, 0), a1_ = PA(P, 8); \
            o[0] = __builtin_amdgcn_mfma_f32_32x32x16_bf16(a0_, VF(L, H, 0), o[0], 0, 0, 0); o[1] = __builtin_amdgcn_mfma_f32_32x32x16_bf16(a0_, VF(L, H, 2), o[1], 0, 0, 0); \
            o[0] = __builtin_amdgcn_mfma_f32_32x32x16_bf16(a1_, VF(L, H, 1), o[0], 0, 0, 0); o[1] = __builtin_amdgcn_mfma_f32_32x32x16_bf16(a1_, VF(L, H, 3), o[1], 0, 0, 0); } while (0)
        { s16x4 la[4], ha[4];
#define PVB(BLK) do { VRD8(la, ha, BLK); asm volatile("s_waitcnt lgkmcnt(0)" ::: "memory"); __builtin_amdgcn_sched_barrier(0); PV4(p[BLK], la, ha); __builtin_amdgcn_sched_barrier(0); } while (0)
          PVB(0); PVB(1); PVB(2); PVB(3); PVB(4);
#undef PVB
        }
#undef PA
#undef VRD
#undef VRD8
#undef VF
#undef PV4
        ALAS float* wsf = (ALAS float*)(sh + LDS_WS) + wid * 64;
        if (hi == 0) wsf[32 + r32] = l;
        LSE[rowq * 6 + h] = m + __builtin_amdgcn_logf(l);
        asm volatile("s_waitcnt lgkmcnt(0)" ::: "memory");
        float rli[16];
#pragma unroll
        for (int r = 0; r < 16; ++r) rli[r] = __builtin_amdgcn_rcpf(wsf[32 + crow(r, hi)]);
        { ALAS bf16_t* stg = (ALAS bf16_t*)(sh + LDS_OST) + wid * 2048;
#pragma unroll
          for (int r = 0; r < 16; ++r) { const int orow = crow(r, hi);
#pragma unroll
            for (int d0 = 0; d0 < 2; ++d0) stg[orow * 64 + d0 * 32 + r32] = (bf16_t)(cvtpk(o[d0][r] * rli[r], 0.f) & 0xffffu); }
          asm volatile("s_waitcnt lgkmcnt(0)" ::: "memory");
#pragma unroll
          for (int i = 0; i < 4; ++i) { const int row = i * 8 + (lane >> 3), ch = lane & 7; const u32x4 v = *(ALAS const u32x4*)(stg + row * 64 + ch * 8);
              const long trow = rowb + (long)dil * (q0 + 32 * wid + row); __builtin_nontemporal_store(v, (u32x4*)(O + trow * 384 + h * 64 + ch * 8));     } }
        __syncthreads();
        if (un >= 3072) break;
        u = un;
    }
}
#undef ALAS
}
constexpr int NWAVES = 8;
constexpr int T_ROWS = 8 * 4096, DM = 1024, INW = 2560, FF = 4096, DEPTH = 2;
constexpr float EPS = 1e-6f;
constexpr float C2 = 0.125f * 1.4426950408889634f;
constexpr size_t MiB = 1u << 20;
constexpr size_t WS_SS = 436 * MiB;
constexpr size_t WS_W = 1 * MiB;
constexpr size_t W_LAYER = 23 * MiB, W_IN = 0, W_O = 5 * MiB, W_1 = 7 * MiB, W_2 = 15 * MiB;
constexpr size_t WS_XB = 48 * MiB;
constexpr size_t WS_Y = 112 * MiB;
constexpr size_t WS_LSE = 176 * MiB;
constexpr size_t WS_Z = 180 * MiB;
constexpr size_t WS_OA = 340 * MiB;
constexpr size_t WS_OC = 412 * MiB;
constexpr size_t WS_H = 180 * MiB;
constexpr size_t WS_CTL = 438 * MiB, CTL_BYTES = 16384;
constexpr size_t WS_END = 439 * MiB;
constexpr int LDS_BARW = 147392;
constexpr int LDS_BYTES = 147456;

#define GAS __attribute__((address_space(1)))
#define LAS __attribute__((address_space(3)))
typedef unsigned short bf16;
typedef unsigned v4u __attribute__((ext_vector_type(4)));
typedef unsigned v2u __attribute__((ext_vector_type(2)));
typedef float f32x4 __attribute__((ext_vector_type(4)));
__device__ __forceinline__ unsigned pk2(float lo, float hi) { unsigned r; asm volatile("v_cvt_pk_bf16_f32 %0, %1, %2" : "=v"(r) : "v"(lo), "v"(hi)); return r; }
__device__ __forceinline__ float bflo(unsigned u) { return __uint_as_float(u << 16); }
__device__ __forceinline__ float bfhi(unsigned u) { return __uint_as_float(u & 0xffff0000u); }
__device__ __forceinline__ float wave_sum(float v) {
#pragma unroll
    for (int o = 1; o < 64; o <<= 1) v += lane_xor(v, o);
    return v;
}
__device__ __forceinline__ void transpose_item(const float* W, int K, int N, bf16* WT, LAS float* scr, int item, int lane, const float* gk, bool qmode) {
    const int nblk = N / 32, kb = item / nblk, nb = item % nblk, k0 = 64 * kb, n0 = 32 * nb;
    const float cs = (qmode && (n0 < 384 || (n0 >= 1920 && n0 < 2304))) ? C2 : 1.0f;
    const int kr = lane >> 3, c4 = lane & 7;
    f32x4 v[8]; float g[8];
#pragma unroll
    for (int i = 0; i < 8; ++i) { const int kk = 8 * i + kr; v[i] = __builtin_nontemporal_load((const f32x4*)(W + (size_t)(k0 + kk) * N + n0 + 4 * c4)); }
    asm volatile("" ::: "memory");
#pragma unroll
    for (int i = 0; i < 8; ++i) g[i] = (gk ? gk : W)[k0 + 8 * i + kr];
#pragma unroll
    for (int i = 0; i < 8; ++i) g[i] = gk ? g[i] * cs : cs;
#pragma unroll
    for (int i = 0; i < 8; ++i) { const int kk = 8 * i + kr; LAS float* d = scr + kk * 33 + 4 * c4; d[0] = v[i].x * g[i]; d[1] = v[i].y * g[i]; d[2] = v[i].z * g[i]; d[3] = v[i].w * g[i]; }
    asm volatile("s_waitcnt lgkmcnt(0)" ::: "memory");
    const int c = lane & 7;
#pragma unroll
    for (int j = 0; j < 4; ++j) { const int n = (lane >> 3) + 8 * j; const LAS float* s = scr + (8 * c) * 33 + n;
        v4u o; o.x = pk2(s[0 * 33], s[1 * 33]); o.y = pk2(s[2 * 33], s[3 * 33]); o.z = pk2(s[4 * 33], s[5 * 33]); o.w = pk2(s[6 * 33], s[7 * 33]);
        *(v4u*)(WT + (size_t)(n0 + n) * K + k0 + 8 * c) = o; }
    asm volatile("s_waitcnt lgkmcnt(0)" ::: "memory");
}
#define RLX_AGENT __ATOMIC_RELAXED, __HIP_MEMORY_SCOPE_AGENT
#define XB_TMO      128
#define XB_XCNT(j)  (256  + 64 * (j))
#define XB_XSUB(j)  (1280 + 64 * (j))
#define XB_XGEN(j)  (2304 + 64 * (j))
#define XB_TOP      3328
#define XB_TOPGEN   3392
#define XCD_BAR_WORDS 3456
#define XB_SPIN_CAP (1u << 18)

__device__ __forceinline__ unsigned xb_ld(unsigned* p)              { return __hip_atomic_load(p, __ATOMIC_RELAXED, __HIP_MEMORY_SCOPE_AGENT); }
__device__ __forceinline__ unsigned xb_add(unsigned* p, unsigned v) { return __hip_atomic_fetch_add(p, v, __ATOMIC_RELAXED, __HIP_MEMORY_SCOPE_AGENT); }
__device__ __forceinline__ unsigned xb_xcc_id() { return (unsigned)__builtin_amdgcn_s_getreg((3 << 11) | 20) & 0xFu; }
#define XB_SPIN(cond, bar) do { unsigned _sp = 0; while (cond) { __builtin_amdgcn_s_sleep(1); \
    if ((++_sp & 255u) == 0u) { if (xb_ld(&(bar)[XB_TMO])) break; if (_sp > XB_SPIN_CAP) { atomicAdd(&(bar)[XB_TMO], 1u); break; } } } } while (0)

struct XcdBarrier {
    unsigned* bar; unsigned x;
    volatile LAS unsigned* st;
};

__device__ __forceinline__ XcdBarrier xcd_barrier_post(unsigned* bar, volatile LAS unsigned* st) {
    XcdBarrier b; b.bar = bar; b.x = xb_xcc_id(); b.st = st;
    if (threadIdx.x == 0) (void)xb_add(&bar[XB_XCNT(b.x)], 1u);
    return b;
}
__device__ __forceinline__ void xcd_barrier_complete(unsigned* bar, unsigned x, unsigned& nloc, unsigned& nx) {
    const unsigned G = gridDim.x * gridDim.y * gridDim.z;
    unsigned sum, cnt, mine, sp = 0u;
    for (;;) {
        sum = 0u; cnt = 0u; mine = 0u;
#pragma unroll
        for (unsigned j = 0; j < 16; ++j) { const unsigned c = xb_ld(&bar[XB_XCNT(j)]); sum += c; cnt += (c > 0u) ? 1u : 0u; mine = (j == x) ? c : mine; }
        if (sum == G) break;
        __builtin_amdgcn_s_sleep(1);
        if ((++sp & 255u) == 0u) { if (xb_ld(&bar[XB_TMO])) break; if (sp > XB_SPIN_CAP) { atomicAdd(&bar[XB_TMO], 1u); break; } }
    }
    nloc = mine > 0u ? mine : 1u; nx = cnt > 0u ? cnt : 1u;
}

__device__ __forceinline__ void xcd_barrier(const XcdBarrier& b, const int wave_id) {
    asm volatile("s_waitcnt vmcnt(0)" ::: "memory");
    __syncthreads();
    if (wave_id == 0 && hw_lane_id() == 0) {
        unsigned* bar = b.bar;
        __builtin_amdgcn_s_waitcnt(0);
        unsigned nloc = b.st[0], nx = b.st[1];
        if (nloc == 0u) { xcd_barrier_complete(bar, b.x, nloc, nx); b.st[0] = nloc; b.st[1] = nx; }
        const unsigned old = xb_add(&bar[XB_XSUB(b.x)], 1u);
        const unsigned gen = old / nloc;
        if (old + 1u == (gen + 1u) * nloc) {
            __builtin_amdgcn_fence(__ATOMIC_RELEASE, "agent");
            asm volatile("s_waitcnt vmcnt(0)" ::: "memory");
            const unsigned og = xb_add(&bar[XB_TOP], 1u);
            const unsigned tg = og / nx;
            if (og + 1u == (tg + 1u) * nx) xb_add(&bar[XB_TOPGEN], 1u);
            else XB_SPIN(xb_ld(&bar[XB_TOPGEN]) == tg, bar);
            __builtin_amdgcn_fence(__ATOMIC_ACQUIRE, "agent");
            xb_add(&bar[XB_XGEN(b.x)], 1u);
            asm volatile("s_waitcnt vmcnt(0)" ::: "memory");
        } else {
            XB_SPIN(xb_ld(&bar[XB_XGEN(b.x)]) == gen, bar);
            __builtin_amdgcn_fence(__ATOMIC_ACQUIRE, "agent");
            asm volatile("s_waitcnt vmcnt(0)" ::: "memory");
        }
    }
    __syncthreads();
}

#ifndef P5_A_NT
#define P5_A_NT false
#endif
#ifndef P5_REV
#define P5_REV 0
#endif
#ifndef P4_WGM
#define P4_WGM 4
#endif
#ifndef P1_WGM
#define P1_WGM 4
#endif
#ifndef REP_P0
#define REP_P0 1
#endif
#ifndef REP_P1
#define REP_P1 1
#endif
#ifndef REP_P2
#define REP_P2 1
#endif
#ifndef REP_P2B
#define REP_P2B 1
#endif
#ifndef REP_P4
#define REP_P4 1
#endif
struct Args { const float* in[11]; float* out; unsigned char* ws; int ph_lo, ph_hi; };
constexpr int N_PHASES = 14;

__global__ void __launch_bounds__(NWAVES * 64, 2) hymba_fwd(Args args) {
    extern __shared__ __attribute__((aligned(16))) unsigned char lds[];
    cg::grid_group grid = cg::this_grid();
    const int wave = __builtin_amdgcn_readfirstlane((int)threadIdx.x >> 6);
    const int G = gridDim.x, gw = blockIdx.x * NWAVES + wave, NGW = G * NWAVES;
    unsigned char* ws = args.ws;
    const float* x_in = args.in[0]; const float* w_in = args.in[1]; const float* conv_w = args.in[2]; const float* sinks = args.in[3];
    const float* g_mix = args.in[4]; const float* g_group = args.in[5]; const float* w_o = args.in[6]; const float* g_mlp = args.in[7];
    const float* w_ff_in = args.in[8]; const float* w_ff_out = args.in[9]; const float* g_final = args.in[10];
    float* out = args.out;
    unsigned long long* SS = (unsigned long long*)(ws + WS_SS);
    constexpr float SSQ = 1.0f / 16777216.0f;
    bf16* XB = (bf16*)(ws + WS_XB); bf16* Y = (bf16*)(ws + WS_Y); float* LSE = (float*)(ws + WS_LSE); bf16* Z = (bf16*)(ws + WS_Z);
    bf16* OA = (bf16*)(ws + WS_OA); bf16* OC = (bf16*)(ws + WS_OC); bf16* HB = (bf16*)(ws + WS_H);
    const int lo = args.ph_lo, hi = args.ph_hi;
    if (threadIdx.x < 2) ((volatile LAS unsigned*)((LAS unsigned char*)lds + LDS_BARW))[threadIdx.x] = 0u;
    __syncthreads();
    (void)xcd_barrier_post((unsigned*)(ws + WS_CTL), (volatile LAS unsigned*)((LAS unsigned char*)lds + LDS_BARW));
    if (args.ph_hi > 1000) grid.sync();
#define IN(k) (lo <= (k) && (k) < hi)
#define SEAM(k) do { if (IN(k) && IN((k) + 1)) { XcdBarrier b_; b_.bar = (unsigned*)(args.ws + WS_CTL); b_.x = xb_xcc_id(); b_.st = (volatile LAS unsigned*)((LAS unsigned char*)lds + LDS_BARW); xcd_barrier(b_, wave); } } while (0)

    if (IN(0)) for (int rep_ = 0; rep_ < REP_P0; ++rep_) {
        int tid = wave * 64 + hw_lane_id(); asm volatile("" : "+v"(tid)); const int lane = tid & 63;
        LAS float* scr = (LAS float*)((LAS unsigned char*)lds + wave * 16384);
        constexpr int I_IN = (DM / 64) * (INW / 32), I_O = (DM / 64) * (DM / 32), I_1 = (DM / 64) * (FF / 32), I_2 = (FF / 64) * (DM / 32), I_L = I_IN + I_O + I_1 + I_2;
        for (int it = gw; it < DEPTH * I_L; it += NGW) {
            const int l = it / I_L; int r = it % I_L; bf16* wb = (bf16*)(ws + WS_W + l * W_LAYER);
            if (r < I_IN) { transpose_item(w_in + (size_t)l * DM * INW, DM, INW, (bf16*)((unsigned char*)wb + W_IN), scr, r, lane, g_mix + l * DM, true); continue; } r -= I_IN;
            if (r < I_O) { transpose_item(w_o + (size_t)l * DM * DM, DM, DM, (bf16*)((unsigned char*)wb + W_O), scr, r, lane, g_group + l * DM, false); continue; } r -= I_O;
            if (r < I_1) { transpose_item(w_ff_in + (size_t)l * DM * FF, DM, FF, (bf16*)((unsigned char*)wb + W_1), scr, r, lane, g_mlp + l * DM, false); continue; } r -= I_1;
            transpose_item(w_ff_out + (size_t)l * FF * DM, FF, DM, (bf16*)((unsigned char*)wb + W_2), scr, r, lane, nullptr, false);
        }
        for (int m0 = gw; m0 < T_ROWS; m0 += 4 * NGW) {
            f32x4 v[4][4];
#pragma unroll
            for (int u = 0; u < 4; ++u) { const int m = min(m0 + u * NGW, T_ROWS - 1); const f32x4* xr = (const f32x4*)(x_in + (size_t)m * DM) + lane;
#pragma unroll
                for (int j = 0; j < 4; ++j) v[u][j] = __builtin_nontemporal_load(xr + 64 * j); }
#pragma unroll
            for (int u = 0; u < 4; ++u) { const int m = m0 + u * NGW; if (m < T_ROWS) { float s = 0.f;
#pragma unroll
                for (int j = 0; j < 4; ++j) s += (v[u][j].x * v[u][j].x + v[u][j].y * v[u][j].y) + (v[u][j].z * v[u][j].z + v[u][j].w * v[u][j].w);
                s = wave_sum(s);
                v2u* o8 = (v2u*)(XB + (size_t)m * DM) + lane;
#pragma unroll
                for (int j = 0; j < 4; ++j) { v2u w; w.x = pk2(v[u][j].x, v[u][j].y); w.y = pk2(v[u][j].z, v[u][j].w); o8[64 * j] = w; }
                if (lane == 0) SS[m] = (unsigned long long)(s * 16777216.0f + 0.5f); } }
        }
        for (int i = blockIdx.x * 512 + tid; i < 4 * T_ROWS; i += G * 512) SS[T_ROWS + i] = 0ull;
    }
    SEAM(0);

    for (int l = 0; l < DEPTH; ++l) {
        const int pb = 1 + 6 * l;
        unsigned char* wl = ws + WS_W + l * W_LAYER;
        if (IN(pb)) for (int rep_ = 0; rep_ < REP_P1; ++rep_) {
            pg8::Gemm g{XB, (const bf16*)(wl + W_IN), T_ROWS, INW, DM}; pg8::StaticOrder S; S.init(T_ROWS, INW, G, (int)blockIdx.x, 0, P1_WGM);
            pg8::EpiScale<0> E{Z, INW, SS + (size_t)(2 * l) * T_ROWS, SSQ / DM, EPS};
            pg8::gemm_phase<pg8::EpiScale<0>, pg8::StaticOrder, true, true>((LAS unsigned char*)lds, g, S, E, wave);
        }
        SEAM(pb);
        if (IN(pb + 1)) for (int rep_ = 0; rep_ < REP_P2; ++rep_) {
            att::attn_phase(Z, OA, OC, LSE, sinks + l * 6, (char*)lds, G, T_ROWS, wave);
        }
        SEAM(pb + 1);
        if (IN(pb + 2)) for (int rep_ = 0; rep_ < REP_P2B; ++rep_) {
            const float* cw = conv_w + l * 768;
            int ln_ = hw_lane_id(); asm volatile("" : "+v"(ln_));
            const int hl = ln_ & 31, hsel = ln_ >> 5, ch = 8 * hl;
            f32x4 cwv[3][2];
#pragma unroll
            for (int i = 0; i < 3; ++i) { cwv[i][0] = *(const f32x4*)(cw + 256 * i + ch); cwv[i][1] = *(const f32x4*)(cw + 256 * i + ch + 4); }
            for (int m0 = 2 * gw; m0 < T_ROWS; m0 += 4 * NGW) {
                v2u oa[2][3][3], oc[2][3]; float ls[2][3][3]; v4u gbv[2], gcv[2][3], xvv[2][3];
#pragma unroll
                for (int u = 0; u < 2; ++u) { const int m = min(m0 + u * 2 * NGW + hsel, T_ROWS - 1); { const int s = m & 4095; const bf16* zr = Z + (size_t)m * INW;
#pragma unroll
                    for (int j = 0; j < 3; ++j) { const int col = 128 * j + 4 * hl, hd = 2 * j + (hl >> 4);
#pragma unroll
                        for (int p = 0; p < 3; ++p) { ls[u][j][p] = LSE[((size_t)p * T_ROWS + m) * 6 + hd]; oa[u][j][p] = *(const v2u*)(OA + ((size_t)p * T_ROWS + m) * 384 + col); }
                        oc[u][j] = *(const v2u*)(OC + (size_t)m * 384 + col); }
                    gbv[u] = *(const v4u*)(zr + 1152 + ch);
#pragma unroll
                    for (int dt = 0; dt < 3; ++dt) { gcv[u][dt] = (v4u){0u, 0u, 0u, 0u}; xvv[u][dt] = (v4u){0u, 0u, 0u, 0u};
                        if (s - dt >= 0) { gcv[u][dt] = *(const v4u*)(zr - (size_t)dt * INW + 1408 + ch); xvv[u][dt] = *(const v4u*)(zr - (size_t)dt * INW + 1664 + ch); } } } }
#pragma unroll
                for (int u = 0; u < 2; ++u) { const int m = m0 + u * 2 * NGW + hsel; if (m < T_ROWS) {
                    float ya[12], yc[12], yb[8]; float ssA = 0.f, ssB = 0.f, ssC = 0.f;
#pragma unroll
                    for (int j = 0; j < 3; ++j) { const float l0 = ls[u][j][0], l1 = ls[u][j][1], l2 = ls[u][j][2];
                        const float mx = __builtin_fmaxf(__builtin_fmaxf(l0, l1), l2);
                        float w0 = __builtin_amdgcn_exp2f(l0 - mx), w1 = __builtin_amdgcn_exp2f(l1 - mx), w2 = __builtin_amdgcn_exp2f(l2 - mx);
                        const float inv = __builtin_amdgcn_rcpf(w0 + w1 + w2); w0 *= inv; w1 *= inv; w2 *= inv;
                        const v2u a0 = oa[u][j][0], a1 = oa[u][j][1], a2 = oa[u][j][2], c0 = oc[u][j];
                        ya[4 * j + 0] = w0 * bflo(a0.x) + w1 * bflo(a1.x) + w2 * bflo(a2.x); ya[4 * j + 1] = w0 * bfhi(a0.x) + w1 * bfhi(a1.x) + w2 * bfhi(a2.x);
                        ya[4 * j + 2] = w0 * bflo(a0.y) + w1 * bflo(a1.y) + w2 * bflo(a2.y); ya[4 * j + 3] = w0 * bfhi(a0.y) + w1 * bfhi(a1.y) + w2 * bfhi(a2.y);
                        yc[4 * j + 0] = bflo(c0.x); yc[4 * j + 1] = bfhi(c0.x); yc[4 * j + 2] = bflo(c0.y); yc[4 * j + 3] = bfhi(c0.y);
#pragma unroll
                        for (int e = 0; e < 4; ++e) { ssA += ya[4 * j + e] * ya[4 * j + e]; ssC += yc[4 * j + e] * yc[4 * j + e]; } }
#pragma unroll
                    for (int q = 0; q < 4; ++q) { const unsigned g = gbv[u][q];
                        const float u0l = bflo(gcv[u][0][q]) * bflo(xvv[u][0][q]), u0h = bfhi(gcv[u][0][q]) * bfhi(xvv[u][0][q]);
                        const float u1l = bflo(gcv[u][1][q]) * bflo(xvv[u][1][q]), u1h = bfhi(gcv[u][1][q]) * bfhi(xvv[u][1][q]);
                        const float u2l = bflo(gcv[u][2][q]) * bflo(xvv[u][2][q]), u2h = bfhi(gcv[u][2][q]) * bfhi(xvv[u][2][q]);
                        const int e0 = 2 * q, e1 = 2 * q + 1;
                        yb[e0] = bflo(g) * (cwv[0][e0 >> 2][e0 & 3] * u2l + cwv[1][e0 >> 2][e0 & 3] * u1l + cwv[2][e0 >> 2][e0 & 3] * u0l);
                        yb[e1] = bfhi(g) * (cwv[0][e1 >> 2][e1 & 3] * u2h + cwv[1][e1 >> 2][e1 & 3] * u1h + cwv[2][e1 >> 2][e1 & 3] * u0h);
                        ssB += yb[e0] * yb[e0] + yb[e1] * yb[e1]; }
#pragma unroll
                    for (int o = 1; o < 32; o <<= 1) { ssA += lane_xor(ssA, o); ssB += lane_xor(ssB, o); ssC += lane_xor(ssC, o); }
                    const float rA = __builtin_amdgcn_rsqf(ssA * (1.0f / 384.0f) + EPS), rB = __builtin_amdgcn_rsqf(ssB * (1.0f / 256.0f) + EPS), rC = __builtin_amdgcn_rsqf(ssC * (1.0f / 384.0f) + EPS);
                    bf16* yr = Y + (size_t)m * DM;
#pragma unroll
                    for (int j = 0; j < 3; ++j) { const int col = 128 * j + 4 * hl;
                        v2u wa; wa.x = pk2(ya[4 * j] * rA, ya[4 * j + 1] * rA); wa.y = pk2(ya[4 * j + 2] * rA, ya[4 * j + 3] * rA); *(v2u*)(yr + col) = wa;
                        v2u wc; wc.x = pk2(yc[4 * j] * rC, yc[4 * j + 1] * rC); wc.y = pk2(yc[4 * j + 2] * rC, yc[4 * j + 3] * rC); *(v2u*)(yr + 640 + col) = wc; }
                    v4u wb; wb.x = pk2(yb[0] * rB, yb[1] * rB); wb.y = pk2(yb[2] * rB, yb[3] * rB); wb.z = pk2(yb[4] * rB, yb[5] * rB); wb.w = pk2(yb[6] * rB, yb[7] * rB);
                    *(v4u*)(yr + 384 + ch) = wb; } }
            }
        }
        SEAM(pb + 2);
#ifdef PROBE_P3
        if (IN(pb + 3)) {
            pg8::Gemm g{Y, (const bf16*)(wl + W_O), T_ROWS, DM, DM}; pg8::StaticOrder S; S.init(T_ROWS, DM, G, (int)blockIdx.x);
            pg8::EpiScale<0> E{XB, DM, SS, SSQ / DM, EPS};
            pg8::gemm_phase<pg8::EpiScale<0>, pg8::StaticOrder, true, true>((LAS unsigned char*)lds, g, S, E, wave);
            grid.sync();
        }
#endif
        if (IN(pb + 3)) {
            pg8::Gemm g{Y, (const bf16*)(wl + W_O), T_ROWS, DM, DM}; pg8::StaticOrder S; S.init(T_ROWS, DM, G, (int)blockIdx.x);
            pg8::EpiResidBT<false> E{XB, SS + (size_t)(2 * l + 1) * T_ROWS, DM, nullptr, 0.f, 0.f};
            pg8::gemm_phase<pg8::EpiResidBT<false>, pg8::StaticOrder, true, true>((LAS unsigned char*)lds, g, S, E, wave);
        }
        SEAM(pb + 3);
        if (IN(pb + 4)) for (int rep_ = 0; rep_ < REP_P4; ++rep_) {
            pg8::Gemm g{XB, (const bf16*)(wl + W_1), T_ROWS, FF, DM}; pg8::StaticOrder S; S.init(T_ROWS, FF, G, (int)blockIdx.x, 0, P4_WGM);
            pg8::EpiScale<1> E{HB, FF, SS + (size_t)(2 * l + 1) * T_ROWS, SSQ / DM, EPS};
            pg8::gemm_phase<pg8::EpiScale<1>, pg8::StaticOrder, true, true>((LAS unsigned char*)lds, g, S, E, wave);
        }
        SEAM(pb + 4);
#ifdef PROBE_P5
        if (IN(pb + 5)) {
            pg8::Gemm g{HB, (const bf16*)(wl + W_2), T_ROWS, DM, FF}; pg8::StaticOrder S; S.init(T_ROWS, DM, G, (int)blockIdx.x);
            pg8::EpiScale<0> E{Y, DM, SS, SSQ / DM, EPS};
            pg8::gemm_phase<pg8::EpiScale<0>, pg8::StaticOrder, true, true>((LAS unsigned char*)lds, g, S, E, wave);
            grid.sync();
        }
#endif
        if (IN(pb + 5)) {
            pg8::Gemm g{HB, (const bf16*)(wl + W_2), T_ROWS, DM, FF}; pg8::StaticOrder S; S.init(T_ROWS, DM, G, (int)blockIdx.x, P5_REV);
            pg8::EpiResidBT<true> E{XB, SS + (size_t)(2 * l + 2) * T_ROWS, DM, SS + (size_t)(2 * l + 1) * T_ROWS, SSQ / DM, EPS};
            pg8::gemm_phase<pg8::EpiResidBT<true>, pg8::StaticOrder, true, true, P5_A_NT>((LAS unsigned char*)lds, g, S, E, wave);
        }
        SEAM(pb + 5);
    }
    if (IN(13)) {
        const unsigned long long* ssf = SS + (size_t)4 * T_ROWS;
        int lane_f = hw_lane_id(); asm volatile("" : "+v"(lane_f));
        f32x4 gv[4];
#pragma unroll
        for (int j = 0; j < 4; ++j) gv[j] = ((const f32x4*)g_final)[lane_f + 64 * j];
        for (int m0 = gw; m0 < T_ROWS; m0 += 4 * NGW) {
            v2u v[4][4]; float r[4];
#pragma unroll
            for (int u = 0; u < 4; ++u) { const int m = min(m0 + u * NGW, T_ROWS - 1); const v2u* xr = (const v2u*)(XB + (size_t)m * DM) + lane_f; r[u] = (float)ssf[m];
#pragma unroll
                for (int j = 0; j < 4; ++j) v[u][j] = xr[64 * j]; }
#pragma unroll
            for (int u = 0; u < 4; ++u) { const int m = m0 + u * NGW; if (m < T_ROWS) { const float rs = __builtin_amdgcn_rsqf(r[u] * (SSQ / DM) + EPS); f32x4* orow = (f32x4*)(out + (size_t)m * DM) + lane_f;
#pragma unroll
                for (int j = 0; j < 4; ++j) __builtin_nontemporal_store((f32x4){bflo(v[u][j].x), bfhi(v[u][j].x), bflo(v[u][j].y), bfhi(v[u][j].y)} * rs * gv[j], orow + 64 * j); } }
        }
    }
#undef IN
#undef SEAM
}

#ifndef MK_N_LAUNCHES
#define MK_N_LAUNCHES 1
#endif
extern "C" void kernel_launch(void* const* d_in, const int* in_sizes, int n_in, void* d_out, int out_size, void* d_ws, size_t ws_size, hipStream_t stream) {
    static int grid = 0;
    if (grid == 0) {
        if (n_in != 11 || out_size != T_ROWS * DM || ws_size < WS_END) { fprintf(stderr, "kernel_launch: unexpected shapes (n_in %d out %d ws %zu)\n", n_in, out_size, ws_size); grid = -1; return; }
        int dev = 0, cus = 0, per_cu = 0;
        hipGetDevice(&dev); hipDeviceGetAttribute(&cus, hipDeviceAttributeMultiprocessorCount, dev);
        hipFuncSetAttribute((const void*)hymba_fwd, hipFuncAttributeMaxDynamicSharedMemorySize, LDS_BYTES);
        hipOccupancyMaxActiveBlocksPerMultiprocessor(&per_cu, (const void*)hymba_fwd, NWAVES * 64, LDS_BYTES);
        if (per_cu < 1) per_cu = 1;
        (void)hipGetLastError();
        grid = cus * per_cu;
    }
    if (grid < 0) return;
    if (MK_N_LAUNCHES == 1) (void)hipMemsetAsync((unsigned char*)d_ws + WS_CTL, 0, CTL_BYTES, stream);
    Args a{};
    for (int i = 0; i < 11; ++i) a.in[i] = (const float*)d_in[i];
    a.out = (float*)d_out; a.ws = (unsigned char*)d_ws;
    if (MK_N_LAUNCHES == 1) {
        a.ph_lo = 0; a.ph_hi = N_PHASES;
        void* kargs[] = {&a};
        hipError_t e = hipLaunchCooperativeKernel((const void*)hymba_fwd, dim3(grid), dim3(NWAVES * 64), kargs, LDS_BYTES, stream);
        if (e != hipSuccess) fprintf(stderr, "cooperative launch failed: %s (grid %d)\n", hipGetErrorString(e), grid);
    } else {
        for (int p = 0; p < N_PHASES; ++p) { a.ph_lo = p; a.ph_hi = p + 1; hipLaunchKernelGGL(hymba_fwd, dim3(grid), dim3(NWAVES * 64), LDS_BYTES, stream, a); }
    }
}
```
